# Optimizing an MI355X kernel written in HIP

```python
import math
import jax, jax.numpy as jnp
from jax import lax
import numpy as np

D_MODEL = 1024
BATCH = 8
SEQ = 4096
DEPTH = 2

N_A_LAYERS = DEPTH // 2
N_B_LAYERS = DEPTH - N_A_LAYERS
SSM_EXPAND = 2
D_INNER = SSM_EXPAND * D_MODEL
SSM_HEAD_DIM = 64
SSM_HEADS = D_INNER // SSM_HEAD_DIM
SSM_GROUPS = 4
SSM_STATE = 128
SSM_CONV = 4
SSM_CHUNK = 128
GN = SSM_GROUPS * SSM_STATE
CONV_DIM = D_INNER + 2 * GN
IN_PROJ_DIM = D_INNER + CONV_DIM + SSM_HEADS
SB_HEADS = 16
SB_HEAD_DIM = D_MODEL // SB_HEADS
SB_BLOCK = 128
D_FF = 2816
FFN_CONV = 3
EPS = 1e-6

kernel_name = 'yoco_mamba2_stickbreaking_convffn'


def rmsnorm(x, w):
    xf = x.astype(jnp.float32)
    y = xf * lax.rsqrt(jnp.mean(xf * xf, axis=-1, keepdims=True) + EPS)
    return (y * w.astype(jnp.float32)).astype(x.dtype)


def causal_dwconv(x, w, b):
    k_w, s = w.shape[0], x.shape[1]
    xp = jnp.pad(x, ((0, 0), (k_w - 1, 0), (0, 0)))
    out = b
    for j in range(k_w):
        out = out + xp[:, j:j + s, :] * w[j]
    return out


def segsum(a):
    t = a.shape[-1]
    cs = jnp.cumsum(a, axis=-1)
    diff = cs[..., :, None] - cs[..., None, :]
    mask = jnp.tril(jnp.ones((t, t), dtype=bool))
    return jnp.where(mask, diff, -jnp.inf)


def ssd_chunked(xs, dt, a, bm, cm):
    bsz, s, h, p = xs.shape
    g, n = bm.shape[2], bm.shape[3]
    r = h // g
    c, l = s // SSM_CHUNK, SSM_CHUNK
    xd = (xs * dt[..., None]).reshape(bsz, c, l, g, r, p)
    ad = (dt * a).reshape(bsz, c, l, g, r).transpose(0, 3, 4, 1, 2)
    bc = bm.reshape(bsz, c, l, g, n)
    cc = cm.reshape(bsz, c, l, g, n)
    a_cs = jnp.cumsum(ad, axis=-1)
    lmat = jnp.exp(segsum(ad))
    cb = jnp.einsum('bclgn,bcsgn->bcgls', cc, bc)
    y_diag = jnp.einsum('bcgls,bgrcls,bcsgrp->bclgrp', cb, lmat, xd)
    decay_states = jnp.exp(a_cs[..., -1:] - a_cs)
    states = jnp.einsum('bclgn,bgrcl,bclgrp->bcgrpn', bc, decay_states, xd)
    chunk_decay = jnp.exp(a_cs[..., -1])

    def step(carry, inp):
        st, dc = inp
        return carry * dc[..., None, None] + st, carry

    init = jnp.zeros((bsz, g, r, p, n), dtype=states.dtype)
    _, prev = lax.scan(step, init, (jnp.moveaxis(states, 1, 0), jnp.moveaxis(chunk_decay, -1, 0)))
    prev = jnp.moveaxis(prev, 0, 1)
    y_off = jnp.einsum('bclgn,bcgrpn,bgrcl->bclgrp', cc, prev, jnp.exp(a_cs))
    return (y_diag + y_off).reshape(bsz, s, h, p)


def mamba2_mixer(u, w_in, conv_w, conv_b, dt_bias, a_log, d_skip, gate_norm_w, w_out):
    bsz, s, _ = u.shape
    f32 = jnp.float32
    zxbcdt = u @ w_in
    z = zxbcdt[..., :D_INNER]
    xbc = zxbcdt[..., D_INNER:D_INNER + CONV_DIM]
    dt = zxbcdt[..., D_INNER + CONV_DIM:]
    xbc = jax.nn.silu(causal_dwconv(xbc, conv_w, conv_b))
    xs = xbc[..., :D_INNER].reshape(bsz, s, SSM_HEADS, SSM_HEAD_DIM).astype(f32)
    bm = xbc[..., D_INNER:D_INNER + GN].reshape(bsz, s, SSM_GROUPS, SSM_STATE).astype(f32)
    cm = xbc[..., D_INNER + GN:].reshape(bsz, s, SSM_GROUPS, SSM_STATE).astype(f32)
    dt = jax.nn.softplus(dt.astype(f32) + dt_bias.astype(f32))
    a = -jnp.exp(a_log.astype(f32))
    y = ssd_chunked(xs, dt, a, bm, cm)
    y = y + d_skip.astype(f32)[:, None] * xs
    y = y.reshape(bsz, s, D_INNER) * jax.nn.silu(z.astype(f32))
    gsz = D_INNER // SSM_GROUPS
    y = rmsnorm(y.reshape(bsz, s, SSM_GROUPS, gsz), gate_norm_w.reshape(SSM_GROUPS, gsz))
    return y.reshape(bsz, s, D_INNER).astype(u.dtype) @ w_out


def stick_breaking_attention(q, k, v):
    bsz, s, h, d = q.shape
    nblk = s // SB_BLOCK
    scale = 1.0 / math.sqrt(d)
    qb = q.reshape(bsz, nblk, SB_BLOCK, h, d).transpose(1, 0, 3, 2, 4)
    kt = k.transpose(0, 2, 1, 3).astype(jnp.float32)
    vt = v.transpose(0, 2, 1, 3).astype(jnp.float32)
    starts = jnp.arange(nblk, dtype=jnp.int32) * SB_BLOCK
    kpos = jnp.arange(s, dtype=jnp.int32)

    def block(args):
        qblk, i0 = args
        qpos = i0 + jnp.arange(SB_BLOCK, dtype=jnp.int32)
        mask = kpos[None, :] < qpos[:, None]
        zl = jnp.einsum('bhqd,bhkd->bhqk', qblk.astype(jnp.float32), kt) * scale
        log_1m = jnp.where(mask, -jax.nn.softplus(zl), 0.0)
        later = lax.cumsum(log_1m, axis=3, reverse=True) - log_1m
        att = jnp.where(mask, jnp.exp(jax.nn.log_sigmoid(zl) + later), 0.0)
        return jnp.einsum('bhqk,bhkd->bhqd', att, vt)

    o = lax.map(block, (qb, starts))
    return o.transpose(1, 0, 3, 2, 4).reshape(bsz, s, h * d).astype(q.dtype)


def conv_ffn(u, w_up, conv_w, conv_b, w_down):
    hid = causal_dwconv(u @ w_up, conv_w, conv_b)
    gate, val = hid[..., :D_FF], hid[..., D_FF:]
    return (jax.nn.silu(gate) * val) @ w_down


def setup_inputs(seed: int = 0) -> dict:
    key = jax.random.key(seed)
    ks = jax.random.split(key, 24)
    f32 = jnp.float32

    def nrm(k, shape, scale):
        return jax.random.normal(k, shape, f32) * scale

    def gain(k, shape):
        return 1.0 + 0.02 * jax.random.normal(k, shape, f32)

    na, nb = N_A_LAYERS, N_B_LAYERS
    dt0 = jnp.exp(jax.random.uniform(ks[5], (na, SSM_HEADS), f32, math.log(1e-3), math.log(1e-1)))
    dt_bias = dt0 + jnp.log(-jnp.expm1(-dt0))
    a_log = jnp.log(jax.random.uniform(ks[6], (na, SSM_HEADS), f32, 1.0, 16.0))
    return {
        'x': jax.random.normal(ks[0], (BATCH, SEQ, D_MODEL), f32),
        'ssm_norm_w': gain(ks[1], (na, D_MODEL)),
        'ssm_in_w': nrm(ks[2], (na, D_MODEL, IN_PROJ_DIM), D_MODEL ** -0.5),
        'ssm_conv_w': nrm(ks[3], (na, SSM_CONV, CONV_DIM), SSM_CONV ** -0.5),
        'ssm_conv_b': nrm(ks[4], (na, CONV_DIM), 0.02),
        'ssm_dt_bias': dt_bias,
        'ssm_a_log': a_log,
        'ssm_d': 1.0 + 0.1 * jax.random.normal(ks[7], (na, SSM_HEADS), f32),
        'ssm_gate_norm_w': gain(ks[8], (na, D_INNER)),
        'ssm_out_w': nrm(ks[9], (na, D_INNER, D_MODEL), D_INNER ** -0.5),
        'kv_norm_w': gain(ks[10], (D_MODEL,)),
        'w_k': nrm(ks[11], (D_MODEL, SB_HEADS * SB_HEAD_DIM), D_MODEL ** -0.5),
        'w_v': nrm(ks[12], (D_MODEL, SB_HEADS * SB_HEAD_DIM), D_MODEL ** -0.5),
        'attn_norm_w': gain(ks[13], (nb, D_MODEL)),
        'w_q': nrm(ks[14], (nb, D_MODEL, SB_HEADS * SB_HEAD_DIM), D_MODEL ** -0.5),
        'w_o': nrm(ks[15], (nb, SB_HEADS * SB_HEAD_DIM, D_MODEL), D_MODEL ** -0.5),
        'ffn_norm_w': gain(ks[16], (DEPTH, D_MODEL)),
        'ffn_up_w': nrm(ks[17], (DEPTH, D_MODEL, 2 * D_FF), D_MODEL ** -0.5),
        'ffn_conv_w': nrm(ks[18], (DEPTH, FFN_CONV, 2 * D_FF), FFN_CONV ** -0.5),
        'ffn_conv_b': nrm(ks[19], (DEPTH, 2 * D_FF), 0.02),
        'ffn_down_w': nrm(ks[20], (DEPTH, D_FF, D_MODEL), D_FF ** -0.5),
        'final_norm_w': gain(ks[21], (D_MODEL,)),
    }


def reference(x, ssm_norm_w, ssm_in_w, ssm_conv_w, ssm_conv_b, ssm_dt_bias, ssm_a_log, ssm_d,
              ssm_gate_norm_w, ssm_out_w, kv_norm_w, w_k, w_v, attn_norm_w, w_q, w_o,
              ffn_norm_w, ffn_up_w, ffn_conv_w, ffn_conv_b, ffn_down_w, final_norm_w):
    bsz, s, _ = x.shape
    h = x
    k_shared = None
    v_shared = None
    for layer in range(DEPTH):
        if layer < N_A_LAYERS:
            i = layer
            h = h + mamba2_mixer(rmsnorm(h, ssm_norm_w[i]), ssm_in_w[i], ssm_conv_w[i], ssm_conv_b[i],
                                 ssm_dt_bias[i], ssm_a_log[i], ssm_d[i], ssm_gate_norm_w[i], ssm_out_w[i])
        else:
            i = layer - N_A_LAYERS
            if k_shared is None:
                hk = rmsnorm(h, kv_norm_w)
                k_shared = (hk @ w_k).reshape(bsz, s, SB_HEADS, SB_HEAD_DIM)
                v_shared = (hk @ w_v).reshape(bsz, s, SB_HEADS, SB_HEAD_DIM)
            q = (rmsnorm(h, attn_norm_w[i]) @ w_q[i]).reshape(bsz, s, SB_HEADS, SB_HEAD_DIM)
            h = h + stick_breaking_attention(q, k_shared, v_shared) @ w_o[i]
        h = h + conv_ffn(rmsnorm(h, ffn_norm_w[layer]), ffn_up_w[layer], ffn_conv_w[layer],
                         ffn_conv_b[layer], ffn_down_w[layer])
    return rmsnorm(h, final_norm_w)
```

```cpp
#include <hip/hip_runtime.h>
#include <hip/hip_cooperative_groups.h>
#include <cstdio>
#include <cstdint>
namespace cg = cooperative_groups;

#define LAS __attribute__((address_space(3)))
typedef unsigned short bf16_t;
typedef short bf16x8 __attribute__((ext_vector_type(8)));
typedef short bf16x4 __attribute__((ext_vector_type(4)));
typedef float f32x4 __attribute__((ext_vector_type(4)));
typedef unsigned u32x4 __attribute__((ext_vector_type(4)));
typedef unsigned u32x2 __attribute__((ext_vector_type(2)));

constexpr int D_MODEL = 1024, BATCH = 8, SEQ = 4096, T = BATCH * SEQ;
constexpr int D_INNER = 2048, SSM_HEADS = 32, GN = 512, CONV_DIM = 3072, IN_PROJ = 5152;
constexpr int ZXW = 5120;
constexpr int NIN_PAD = 5376;
constexpr int D_FF = 2816, FF2 = 5632;
constexpr int KVQW = 3072;
constexpr float EPS = 1e-6f;

constexpr size_t MiB = 1u << 20;
constexpr size_t WS_WIN = 1 * MiB, WS_WOUT = 12 * MiB, WS_WKVQ = 16 * MiB, WS_WO = 22 * MiB, WS_WUP = 24 * MiB, WS_WDN = 46 * MiB;
constexpr size_t WS_DT = 57 * MiB, WS_SSQ = 61 * MiB, WS_XN = 66 * MiB, WS_BIG = 132 * MiB;
constexpr size_t WS_ZX = WS_BIG;
constexpr size_t WS_ACT = WS_BIG;
constexpr size_t WS_AO = WS_BIG;
constexpr size_t WS_KVQ = 308 * MiB;
constexpr size_t WS_END = 500 * MiB;

constexpr int NTHREADS = 512;
constexpr int LDS_BYTES = 161792;

__device__ __forceinline__ unsigned cvt_pk_bf16(float lo, float hi) { unsigned r; asm volatile("v_cvt_pk_bf16_f32 %0, %1, %2" : "=v"(r) : "v"(lo), "v"(hi)); return r; }
__device__ __forceinline__ float bf2f(unsigned short u) { return __uint_as_float((unsigned)u << 16); }
__device__ __forceinline__ float bflo(unsigned u) { return __uint_as_float(u << 16); }
__device__ __forceinline__ float bfhi(unsigned u) { return __uint_as_float(u & 0xffff0000u); }
__device__ __forceinline__ float wave_sum(float v) {
#pragma unroll
    for (int o = 1; o < 64; o <<= 1) v += __shfl_xor(v, o);
    return v;
}
__device__ __forceinline__ float silu_f(float x) { return x / (1.f + __expf(-x)); }
__device__ __forceinline__ float softplus_f(float x) { return fmaxf(x, 0.f) + log1pf(__expf(-fabsf(x))); }
__device__ __forceinline__ float rot_row(float v, int which) {
    int iv = __builtin_bit_cast(int, v), r;
    if (which == 1) r = __builtin_amdgcn_update_dpp(0, iv, 0x121, 0xf, 0xf, false);
    else r = __builtin_amdgcn_update_dpp(0, iv, 0x122, 0xf, 0xf, false);
    return __builtin_bit_cast(float, r);
}

__device__ __forceinline__ float shr_row(float cur, float prev, int n) {
    const int ic = __builtin_bit_cast(int, cur), ip = __builtin_bit_cast(int, prev); int r;
    if (n == 1) { const int t = __builtin_amdgcn_update_dpp(0, ip, 0x121, 0xf, 0xf, false); r = __builtin_amdgcn_update_dpp(t, ic, 0x111, 0xf, 0xf, false); }
    else { const int t = __builtin_amdgcn_update_dpp(0, ip, 0x122, 0xf, 0xf, false); r = __builtin_amdgcn_update_dpp(t, ic, 0x112, 0xf, 0xf, false); }
    return __builtin_bit_cast(float, r);
}
namespace pg8 {
constexpr int BM = 256, BK = 64, HALF = 128, HTB = HALF * BK * 2, STAGE_BYTES = 8 * HTB, NXCD = 8, WGM = 8;
__host__ __device__ __forceinline__ int lds_byte(int r, int c) { const int st = (r >> 4) * 2 + (c >> 5), rr = r & 15, cc = c & 31, ob = rr * 64 + cc * 2; return st * 1024 + (ob ^ (((ob >> 9) & 1) << 5)); }
__host__ __device__ __forceinline__ void stage_rc(int b, int& R, int& C) { const int st = b / 1024, sb = b % 1024, swz = sb ^ (((sb >> 9) & 1) << 5); R = (st >> 1) * 16 + swz / 64; C = (st & 1) * 32 + (swz % 64) / 2; }
__host__ __device__ __forceinline__ int perm32(int rho) { const int n = rho >> 4, i = rho & 15; return 8 * (i >> 2) + 4 * n + (i & 3); }

struct Unit { int pm, pn; };
struct Gemm { const bf16_t* A; const bf16_t* Bt; };

template <int nM, int nN>
struct StaticOrder {
    static constexpr int nwg = nM * nN;
    int G, c;
    __device__ void init(int G_, int c_) { G = G_; c = c_; }
    __device__ bool next(int i, Unit& u) const {
        const int L = i * G + c; if (L >= nwg) return false;
        int wgid = L; { constexpr int q = nwg / NXCD, r = nwg % NXCD; const int xcd = wgid % NXCD, off = wgid / NXCD; wgid = (xcd < r ? xcd * (q + 1) : r * (q + 1) + (xcd - r) * q) + off; }
        constexpr int nig = WGM * nN; const int gid = wgid / nig, fm = gid * WGM, gsz = (nM - fm) < WGM ? (nM - fm) : WGM;
        u.pm = fm + ((wgid % nig) % gsz); u.pn = (wgid % nig) / gsz; return true;
    }
};

template <class Epi, bool AMAP62, bool ALIGN_EPI, int K, int lda, class Sched>
__device__ __forceinline__ void gemm_phase(LAS unsigned char* lds, const Gemm g, const Sched& S, const Epi& E) {
    const int tid = threadIdx.x, wid = __builtin_amdgcn_readfirstlane(tid >> 6), lane = tid & 63, wr = wid >> 2, wc = wid & 3, fr = lane & 15, fq = lane >> 4;
    constexpr int nt = K / BK;
    unsigned voffA[2], voffB[2];
#pragma unroll
    for (int i = 0; i < 2; ++i) { int R, C; stage_rc(tid * 16 + i * 8192, R, C); const int Rb = Epi::PERM ? ((R & ~31) + perm32(R & 31)) : R;
        const int Ra = AMAP62 ? (62 * (R >> 6) + (R & 63)) : R;
        voffA[i] = (unsigned)(Ra * lda + C) * 2u; voffB[i] = (unsigned)(Rb * K + C) * 2u; }
    constexpr size_t kstep = (size_t)(BK * 2);
    constexpr size_t hstepA = (size_t)(AMAP62 ? 124 : 128) * lda * 2, tstepA = (size_t)(AMAP62 ? 248 : 256) * lda * 2;
    constexpr size_t hstepB = (size_t)HALF * K * 2, tstepB = 2 * hstepB;
    const char* baseA = (const char*)g.A - (AMAP62 ? (size_t)2 * lda * 2 : (size_t)0);
    const unsigned ldsw = (unsigned)wid * 1024u;
    const int aoff = lds_byte(wr * 64 + fr, fq * 8), boff = lds_byte(wc * 32 + fr, fq * 8);
#define PG8_SA(b, h) (((b) * 2 + (h)) * HTB)
#define PG8_SB(b, h) ((4 + (b) * 2 + (h)) * HTB)
#define PG8_STAGE(bufoff, gbase, voff) do { _Pragma("unroll") for (int _i = 0; _i < 2; ++_i) \
        __builtin_amdgcn_global_load_lds((const unsigned*)((const char*)(gbase) + (voff)[_i]), (LAS unsigned*)(lds + (bufoff) + ldsw + _i * 8192), 16, 0, 0); } while (0)
#define PG8_LDA(dst, b, h) do { _Pragma("unroll") for (int m = 0; m < 4; ++m) _Pragma("unroll") for (int k = 0; k < 2; ++k) dst[m][k] = *(const LAS bf16x8*)(lds + PG8_SA(b, h) + aoff + m * 2048 + k * 1024); } while (0)
#define PG8_LDB(dst, b, h) do { _Pragma("unroll") for (int n = 0; n < 2; ++n) _Pragma("unroll") for (int k = 0; k < 2; ++k) dst[n][k] = *(const LAS bf16x8*)(lds + PG8_SB(b, h) + boff + n * 2048 + k * 1024); } while (0)
#define PG8_MMA(ai, bj, At, Bt) do { __builtin_amdgcn_s_setprio(1); _Pragma("unroll") for (int m = 0; m < 4; ++m) _Pragma("unroll") for (int n = 0; n < 2; ++n) _Pragma("unroll") for (int k = 0; k < 2; ++k) \
        acc[ai][bj][m][n] = __builtin_amdgcn_mfma_f32_16x16x32_bf16(Bt[n][k], At[m][k], acc[ai][bj][m][n], 0, 0, 0); __builtin_amdgcn_s_setprio(0); } while (0)
#define PG8_WAIT_V(n) asm volatile("s_waitcnt vmcnt(" #n ")" ::: "memory")
#define PG8_WAIT_L(n) asm volatile("s_waitcnt lgkmcnt(" #n ")" ::: "memory")
#define PG8_BAR __builtin_amdgcn_s_barrier()
#define PG8_SCHED __builtin_amdgcn_sched_barrier(0)
    Unit cur, nxt; int ui = 0;
    if (!S.next(0, cur)) return;
    f32x4 acc[2][2][4][2];
#pragma unroll
    for (int a = 0; a < 2; ++a)
#pragma unroll
        for (int b = 0; b < 2; ++b)
#pragma unroll
            for (int m = 0; m < 4; ++m)
#pragma unroll
                for (int n = 0; n < 2; ++n) acc[a][b][m][n] = (f32x4){0.f, 0.f, 0.f, 0.f};
    bf16x8 At[4][2], B0[2][2], B1[2][2];
    const char* cA = baseA + (size_t)cur.pm * tstepA; const char* cB = (const char*)g.Bt + (size_t)cur.pn * tstepB;
    PG8_STAGE(PG8_SB(0, 0), cB, voffB); PG8_STAGE(PG8_SB(0, 1), cB + hstepB, voffB); PG8_STAGE(PG8_SA(0, 0), cA, voffA); PG8_STAGE(PG8_SA(0, 1), cA + hstepA, voffA);
    if (wr == 1) PG8_BAR;
    PG8_WAIT_V(2); PG8_BAR;
    PG8_STAGE(PG8_SB(1, 0), cB + kstep, voffB); PG8_STAGE(PG8_SA(1, 0), cA + kstep, voffA); PG8_STAGE(PG8_SB(1, 1), cB + hstepB + kstep, voffB);
    PG8_WAIT_V(6); PG8_BAR;
    for (;;) {
        const bool has_next = S.next(ui + 1, nxt);
        const char* nA = has_next ? baseA + (size_t)nxt.pm * tstepA : cA; const char* nB = has_next ? (const char*)g.Bt + (size_t)nxt.pn * tstepB : cB;
        for (int t = 0; t < nt; t += 2) {
            const bool last = (t == nt - 2);
            const char* a1 = cA + (size_t)(t + 1) * kstep;
            const char* a2 = last ? nA : cA + (size_t)(t + 2) * kstep; const char* b2 = last ? nB : cB + (size_t)(t + 2) * kstep;
            const char* a3 = a2 + kstep; const char* b3 = b2 + kstep;
            PG8_LDB(B0, 0, 0); PG8_LDB(B1, 0, 1); PG8_SCHED; PG8_LDA(At, 0, 0); PG8_STAGE(PG8_SA(1, 1), a1 + hstepA, voffA);
            PG8_WAIT_V(8); PG8_WAIT_L(0); PG8_BAR; PG8_MMA(0, 0, At, B0); PG8_MMA(0, 1, At, B1); PG8_BAR; PG8_SCHED;
            PG8_LDA(At, 0, 1); PG8_STAGE(PG8_SB(0, 0), b2, voffB); PG8_STAGE(PG8_SB(0, 1), b2 + hstepB, voffB); PG8_STAGE(PG8_SA(0, 0), a2, voffA);
            PG8_WAIT_V(8); PG8_WAIT_L(0); PG8_BAR; PG8_MMA(1, 0, At, B0); PG8_MMA(1, 1, At, B1); PG8_BAR; PG8_SCHED;
            PG8_LDB(B0, 1, 0); PG8_LDB(B1, 1, 1); PG8_SCHED; PG8_LDA(At, 1, 0); PG8_STAGE(PG8_SA(0, 1), a2 + hstepA, voffA);
            PG8_WAIT_V(8); PG8_WAIT_L(0); PG8_BAR; PG8_MMA(0, 0, At, B0); PG8_MMA(0, 1, At, B1); PG8_BAR; PG8_SCHED;
            PG8_LDA(At, 1, 1); PG8_STAGE(PG8_SB(1, 0), b3, voffB); PG8_STAGE(PG8_SB(1, 1), b3 + hstepB, voffB); PG8_STAGE(PG8_SA(1, 0), a3, voffA);
            PG8_WAIT_V(8); PG8_WAIT_L(0); PG8_BAR; PG8_MMA(1, 0, At, B0); PG8_MMA(1, 1, At, B1); PG8_BAR; PG8_SCHED;
        }
        if constexpr (ALIGN_EPI) { if (wr == 0) PG8_BAR; }
        E(acc, cur, wr, wc, fr, fq);
        if (!has_next) break;
#pragma unroll
        for (int a = 0; a < 2; ++a)
#pragma unroll
            for (int b = 0; b < 2; ++b)
#pragma unroll
                for (int m = 0; m < 4; ++m)
#pragma unroll
                    for (int n = 0; n < 2; ++n) acc[a][b][m][n] = (f32x4){0.f, 0.f, 0.f, 0.f};
        cur = nxt; cA = nA; cB = nB; ++ui;
        if constexpr (ALIGN_EPI) { if (wr == 1) PG8_BAR; }
    }
    PG8_WAIT_V(0);
    if constexpr (!ALIGN_EPI) { if (wr == 0) PG8_BAR; }
    PG8_BAR;
#undef PG8_SA
#undef PG8_SB
#undef PG8_STAGE
#undef PG8_LDA
#undef PG8_LDB
#undef PG8_MMA
#undef PG8_WAIT_V
#undef PG8_WAIT_L
#undef PG8_BAR
#undef PG8_SCHED
}

struct EpiBf16 {
    static constexpr bool PERM = true;
    bf16_t* O; int ldc;
    __device__ __forceinline__ void operator()(const f32x4 (&acc)[2][2][4][2], const Unit& u, int wr, int wc, int fr, int fq) const {
        const int row0 = u.pm * BM + wr * 64 + fr, col0 = u.pn * BM + wc * 32 + 8 * fq;
#pragma unroll
        for (int ai = 0; ai < 2; ++ai)
#pragma unroll
            for (int m = 0; m < 4; ++m) { bf16_t* rowp = O + (size_t)(row0 + ai * HALF + m * 16) * ldc + col0;
#pragma unroll
                for (int bj = 0; bj < 2; ++bj) { const f32x4 v0 = acc[ai][bj][m][0], v1 = acc[ai][bj][m][1];
                    u32x4 w; w.x = cvt_pk_bf16(v0[0], v0[1]); w.y = cvt_pk_bf16(v0[2], v0[3]); w.z = cvt_pk_bf16(v1[0], v1[1]); w.w = cvt_pk_bf16(v1[2], v1[3]);
                    *(u32x4*)(rowp + bj * HALF) = w; } }
    }
};
struct EpiInProj {
    static constexpr bool PERM = true;
    bf16_t* ZX; float* DT; const float* dt_bias;
    __device__ __forceinline__ void operator()(const f32x4 (&acc)[2][2][4][2], const Unit& u, int wr, int wc, int fr, int fq) const {
        const int row0 = u.pm * BM + wr * 64 + fr;
        if (u.pn < 20) {
            const int col0 = u.pn * BM + wc * 32 + 8 * fq;
#pragma unroll
            for (int ai = 0; ai < 2; ++ai)
#pragma unroll
                for (int m = 0; m < 4; ++m) { bf16_t* rowp = ZX + (size_t)(row0 + ai * HALF + m * 16) * ZXW + col0;
#pragma unroll
                    for (int bj = 0; bj < 2; ++bj) { const f32x4 v0 = acc[ai][bj][m][0], v1 = acc[ai][bj][m][1];
                        u32x4 w; w.x = cvt_pk_bf16(v0[0], v0[1]); w.y = cvt_pk_bf16(v0[2], v0[3]); w.z = cvt_pk_bf16(v1[0], v1[1]); w.w = cvt_pk_bf16(v1[2], v1[3]);
                        *(u32x4*)(rowp + bj * HALF) = w; } }
        } else if (wc == 0) {
            const int col0 = 8 * fq;
            const f32x4 b0 = *(const f32x4*)(dt_bias + col0), b1 = *(const f32x4*)(dt_bias + col0 + 4);
#pragma unroll
            for (int ai = 0; ai < 2; ++ai)
#pragma unroll
                for (int m = 0; m < 4; ++m) { float* rowp = DT + (size_t)(row0 + ai * HALF + m * 16) * 32 + col0;
                    f32x4 v0 = acc[ai][0][m][0] + b0, v1 = acc[ai][0][m][1] + b1;
#pragma unroll
                    for (int j = 0; j < 4; ++j) { v0[j] = softplus_f(v0[j]); v1[j] = softplus_f(v1[j]); }
                    *(f32x4*)rowp = v0; *(f32x4*)(rowp + 4) = v1; }
        }
    }
};
struct EpiRes {
    static constexpr bool PERM = false;
    const float* base; float* out;
    __device__ __forceinline__ void operator()(const f32x4 (&acc)[2][2][4][2], const Unit& u, int wr, int wc, int fr, int fq) const {
        const int col0 = u.pn * BM + wc * 32 + 4 * fq;
#pragma unroll
        for (int ai = 0; ai < 2; ++ai)
#pragma unroll
            for (int m = 0; m < 4; ++m) { const size_t off = (size_t)(u.pm * BM + ai * HALF + wr * 64 + m * 16 + fr) * D_MODEL + col0;
#pragma unroll
                for (int bj = 0; bj < 2; ++bj)
#pragma unroll
                    for (int n = 0; n < 2; ++n) { const size_t o = off + bj * HALF + n * 16; const f32x4 b = *(const f32x4*)(base + o); *(f32x4*)(out + o) = b + acc[ai][bj][m][n]; } }
    }
};
struct EpiFfn {
    static constexpr bool PERM = true;
    bf16_t* ACT; const float* cw; const float* cb;
    __device__ __forceinline__ void operator()(const f32x4 (&acc)[2][2][4][2], const Unit& u, int wr, int wc, int fr, int fq) const {
#pragma unroll
        for (int n = 0; n < 2; ++n) {
            const int ch = u.pn * 128 + wc * 32 + 8 * fq + 4 * n;
            const f32x4 gw0 = *(const f32x4*)(cw + ch), gw1 = *(const f32x4*)(cw + FF2 + ch), gw2 = *(const f32x4*)(cw + 2 * FF2 + ch), gb = *(const f32x4*)(cb + ch);
            const f32x4 vw0 = *(const f32x4*)(cw + D_FF + ch), vw1 = *(const f32x4*)(cw + FF2 + D_FF + ch), vw2 = *(const f32x4*)(cw + 2 * FF2 + D_FF + ch), vb = *(const f32x4*)(cb + D_FF + ch);
#pragma unroll
            for (int ai = 0; ai < 2; ++ai) {
                const int trow0 = u.pm * 248 + 62 * (2 * ai + wr) - 2;
#pragma unroll
                for (int m = 0; m < 4; ++m) {
                    const f32x4 xg = acc[ai][0][m][n], xv = acc[ai][1][m][n];
                    const f32x4 og = acc[ai][0][m > 0 ? m - 1 : 0][n], ov = acc[ai][1][m > 0 ? m - 1 : 0][n];
                    f32x4 g1, g2, v1, v2;
#pragma unroll
                    for (int j = 0; j < 4; ++j) { g1[j] = shr_row(xg[j], og[j], 1); g2[j] = shr_row(xg[j], og[j], 2); v1[j] = shr_row(xv[j], ov[j], 1); v2[j] = shr_row(xv[j], ov[j], 2); }
                    const int i = 16 * m + fr, t = trow0 + i, pos = t & (SEQ - 1);
                    if (pos == 0) { g1 = (f32x4){0.f, 0.f, 0.f, 0.f}; v1 = g1; }
                    if (pos <= 1) { g2 = (f32x4){0.f, 0.f, 0.f, 0.f}; v2 = g2; }
                    const f32x4 cgv = gb + gw0 * g2 + gw1 * g1 + gw2 * xg, cvv = vb + vw0 * v2 + vw1 * v1 + vw2 * xv;
                    float a[4];
#pragma unroll
                    for (int j = 0; j < 4; ++j) a[j] = silu_f(cgv[j]) * cvv[j];
                    if (i >= 2 && t < T) { u32x2 w; w.x = cvt_pk_bf16(a[0], a[1]); w.y = cvt_pk_bf16(a[2], a[3]); *(u32x2*)(ACT + (size_t)t * D_FF + ch) = w; }
                    asm volatile("" ::: "memory");
                }
            }
        }
    }
};
}

struct Args {
    const float* in[22];
    float* out; unsigned char* ws;
    int ph_lo, ph_hi;
};
typedef const __attribute__((address_space(4))) Args CArgs;

__device__ __forceinline__ void transpose_item(const float* W, int K, int N, bf16_t* WTrow0  , const float* kscale, LAS float* scr, int k0, int n0, int lane) {
#pragma unroll 8
    for (int i = 0; i < 32; ++i) { const int kk = 2 * i + (lane >> 5); float v = W[(size_t)(k0 + kk) * N + n0 + (lane & 31)]; if (kscale) v *= kscale[k0 + kk]; scr[kk * 33 + (lane & 31)] = v; }
    asm volatile("s_waitcnt lgkmcnt(0)" ::: "memory");
    const int c = lane & 7;
#pragma unroll
    for (int j = 0; j < 4; ++j) { const int n = (lane >> 3) + 8 * j; const LAS float* s = scr + (8 * c) * 33 + n;
        u32x4 o; o.x = cvt_pk_bf16(s[0 * 33], s[1 * 33]); o.y = cvt_pk_bf16(s[2 * 33], s[3 * 33]); o.z = cvt_pk_bf16(s[4 * 33], s[5 * 33]); o.w = cvt_pk_bf16(s[6 * 33], s[7 * 33]);
        *(u32x4*)(WTrow0 + (size_t)n * K + k0 + 8 * c) = o; }
    asm volatile("s_waitcnt lgkmcnt(0)" ::: "memory");
}
__device__ __forceinline__ void rms_rows_bf16(const float* X, bf16_t* O, int gw, int NGW, int lane) {
    for (int m = gw; m < T; m += NGW) {
        const f32x4* xr = (const f32x4*)(X + (size_t)m * D_MODEL) + lane;
        f32x4 v[4]; float s = 0.f;
#pragma unroll
        for (int j = 0; j < 4; ++j) { v[j] = xr[64 * j]; s += (v[j].x * v[j].x + v[j].y * v[j].y) + (v[j].z * v[j].z + v[j].w * v[j].w); }
        const float rstd = rsqrtf(wave_sum(s) * (1.f / D_MODEL) + EPS);
        u32x2* o8 = (u32x2*)(O + (size_t)m * D_MODEL) + lane;
#pragma unroll
        for (int j = 0; j < 4; ++j) { u32x2 w; w.x = cvt_pk_bf16(v[j].x * rstd, v[j].y * rstd); w.y = cvt_pk_bf16(v[j].z * rstd, v[j].w * rstd); o8[64 * j] = w; }
    }
}

__device__ __forceinline__ void p0_prologue(CArgs& a, LAS unsigned char* lds, int gw, int NGW, int wave, int lane) {
    LAS float* scr = (LAS float*)(lds + wave * 16384);
    unsigned char* ws = a.ws;
    const float* ssm_norm_w = a.in[1]; const float* ssm_in_w = a.in[2]; const float* gate_norm_w = a.in[8]; const float* ssm_out_w = a.in[9];
    const float* kv_norm_w = a.in[10]; const float* w_k = a.in[11]; const float* w_v = a.in[12]; const float* attn_norm_w = a.in[13]; const float* w_q = a.in[14]; const float* w_o = a.in[15];
    const float* ffn_norm_w = a.in[16]; const float* ffn_up_w = a.in[17]; const float* ffn_down_w = a.in[20];
    bf16_t* WIN = (bf16_t*)(ws + WS_WIN); bf16_t* WOUT = (bf16_t*)(ws + WS_WOUT); bf16_t* WKVQ = (bf16_t*)(ws + WS_WKVQ); bf16_t* WO = (bf16_t*)(ws + WS_WO);
    bf16_t* WUP = (bf16_t*)(ws + WS_WUP); bf16_t* WDN = (bf16_t*)(ws + WS_WDN);
    constexpr int I_IN = 16 * 161, I_OUT = 32 * 32, I_SQ = 16 * 32, I_UP = 16 * 176, I_DN = 44 * 32;
    constexpr int NITEMS = I_IN + I_OUT + 4 * I_SQ + 2 * I_UP + 2 * I_DN;
    for (int it = gw; it < NITEMS; it += NGW) {
        int r = it;
        if (r < I_IN) { const int kb = r / 161, nb = r % 161; transpose_item(ssm_in_w, 1024, IN_PROJ, WIN + (size_t)(32 * nb) * 1024, ssm_norm_w, scr, 64 * kb, 32 * nb, lane); continue; } r -= I_IN;
        if (r < I_OUT) { const int kb = r / 32, nb = r % 32; transpose_item(ssm_out_w, 2048, 1024, WOUT + (size_t)(32 * nb) * 2048, gate_norm_w, scr, 64 * kb, 32 * nb, lane); continue; } r -= I_OUT;
        if (r < I_SQ) { const int kb = r / 32, nb = r % 32; transpose_item(w_k, 1024, 1024, WKVQ + (size_t)(32 * nb) * 1024, kv_norm_w, scr, 64 * kb, 32 * nb, lane); continue; } r -= I_SQ;
        if (r < I_SQ) { const int kb = r / 32, nb = r % 32; transpose_item(w_v, 1024, 1024, WKVQ + (size_t)(1024 + 32 * nb) * 1024, kv_norm_w, scr, 64 * kb, 32 * nb, lane); continue; } r -= I_SQ;
        if (r < I_SQ) { const int kb = r / 32, nb = r % 32; transpose_item(w_q, 1024, 1024, WKVQ + (size_t)(2048 + 32 * nb) * 1024, attn_norm_w, scr, 64 * kb, 32 * nb, lane); continue; } r -= I_SQ;
        if (r < I_SQ) { const int kb = r / 32, nb = r % 32; transpose_item(w_o, 1024, 1024, WO + (size_t)(32 * nb) * 1024, nullptr, scr, 64 * kb, 32 * nb, lane); continue; } r -= I_SQ;
        if (r < 2 * I_UP) { const int l = r / I_UP; r -= l * I_UP; const int kb = r / 176, nb = r % 176; const int n0 = 32 * nb;
            const int drow = n0 < D_FF ? 256 * (n0 / 128) + (n0 % 128) : 256 * ((n0 - D_FF) / 128) + 128 + ((n0 - D_FF) % 128);
            transpose_item(ffn_up_w + (size_t)l * 1024 * FF2, 1024, FF2, WUP + (size_t)l * FF2 * 1024 + (size_t)drow * 1024, ffn_norm_w + l * 1024, scr, 64 * kb, n0, lane); continue; } r -= 2 * I_UP;
        { const int l = r / I_DN; r -= l * I_DN; const int kb = r / 32, nb = r % 32;
            transpose_item(ffn_down_w + (size_t)l * D_FF * 1024, D_FF, 1024, WDN + (size_t)l * 1024 * D_FF + (size_t)(32 * nb) * D_FF, nullptr, scr, 64 * kb, 32 * nb, lane); }
    }
    { u32x4* z = (u32x4*)(WIN + (size_t)IN_PROJ * 1024); const int n16 = 224 * 1024 * 2 / 16;
      for (int i = gw * 64 + lane; i < n16; i += NGW * 64) z[i] = (u32x4){0u, 0u, 0u, 0u}; }
    rms_rows_bf16(a.in[0], (bf16_t*)(ws + WS_XN), gw, NGW, lane);
}

constexpr int SST = 136;
constexpr int L_BS = 0, L_BTW = 34816, L_CS = 69632, L_MS = 104448, L_XDT = 139264, L_ACS = 156672, L_DTS = 157696, L_SSQ = 158720;
static_assert(L_SSQ + 2048 <= LDS_BYTES, "ssd lds");

template <int NR>
__device__ __forceinline__ void conv_half(const u32x4 (&raw)[7], const float* cw, const float* cb, int chan4, int half, float (&outv)[4][4]) {
    f32x4 w[4];
#pragma unroll
    for (int j = 0; j < 4; ++j) w[j] = *(const f32x4*)(cw + j * CONV_DIM + chan4);
    const f32x4 b = *(const f32x4*)(cb + chan4);
#pragma unroll
    for (int k = 0; k < NR; ++k)
#pragma unroll
        for (int i = 0; i < 4; ++i) {
            float s = b[i];
#pragma unroll
            for (int j = 0; j < 4; ++j) { const unsigned wd = raw[k + j][2 * half + (i >> 1)]; const float x = (i & 1) ? bfhi(wd) : bflo(wd); s += w[j][i] * x; }
            outv[k][i] = silu_f(s);
        }
}

__device__ __forceinline__ void ssd_phase(CArgs& a, LAS unsigned char* lds, int tid, int wave, int lane) {
    unsigned char* ws = a.ws;
    bf16_t* ZX = (bf16_t*)(ws + WS_ZX); const float* DT = (const float*)(ws + WS_DT); float* SSQ = (float*)(ws + WS_SSQ);
    const float* conv_w = a.in[3]; const float* conv_b = a.in[4]; const float* a_log = a.in[6]; const float* d_skip = a.in[7];
    const int fr = lane & 15, fq = lane >> 4, pt = wave & 3, lh = wave >> 2;
    LAS bf16_t* Bs = (LAS bf16_t*)(lds + L_BS); LAS bf16_t* Btw = (LAS bf16_t*)(lds + L_BTW); LAS bf16_t* Cs = (LAS bf16_t*)(lds + L_CS);
    LAS bf16_t* Ms = (LAS bf16_t*)(lds + L_MS); LAS bf16_t* XDt = (LAS bf16_t*)(lds + L_XDT);
    LAS float* ssqp = (LAS float*)(lds + L_SSQ);
    for (int unit = blockIdx.x; unit < BATCH * SSM_HEADS; unit += gridDim.x) {
        const int b = unit >> 5, h = unit & 31, g = h >> 3;
        const float Acoef = -__expf(a_log[h]), Dsk = d_skip[h];
        f32x4 St[8];
#pragma unroll
        for (int i = 0; i < 8; ++i) St[i] = (f32x4){0.f, 0.f, 0.f, 0.f};
        for (int c = 0; c < SEQ / 128; ++c) {
            const int t0 = b * SEQ + c * 128;
            LAS float* acs = (LAS float*)(lds + L_ACS + (c & 1) * 512); LAS float* dts = (LAS float*)(lds + L_DTS + (c & 1) * 512);
            if (wave == 0) {
                const float d0 = DT[(size_t)(t0 + 2 * lane) * 32 + h], d1 = DT[(size_t)(t0 + 2 * lane + 1) * 32 + h];
                const float a0 = d0 * Acoef, a1 = d1 * Acoef; float s = a0 + a1;
#pragma unroll
                for (int o = 1; o < 64; o <<= 1) { const float n = __shfl_up(s, o); if (lane >= o) s += n; }
                acs[2 * lane] = s - a1; acs[2 * lane + 1] = s; dts[2 * lane] = d0; dts[2 * lane + 1] = d1;
            }
            __syncthreads();
            const float acs_last = acs[127];
            {
                const int grp = tid & 15, l0 = (tid >> 4) * 4;
                float wd[4];
#pragma unroll
                for (int k = 0; k < 4; ++k) wd[k] = __expf(acs_last - acs[l0 + k]);
#pragma unroll 1
                for (int which = 0; which < 2; ++which) {
                    const int chan = D_INNER + which * GN + g * 128 + grp * 8;
                    const bf16_t* src = ZX + (size_t)(t0 + l0 - 3) * ZXW + D_INNER + chan;
                    u32x4 raw[7];
#pragma unroll
                    for (int r = 0; r < 7; ++r) { if (c == 0 && l0 + r < 3) raw[r] = (u32x4){0u, 0u, 0u, 0u}; else raw[r] = *(const u32x4*)(src + (size_t)r * ZXW); }
                    LAS bf16_t* dst = which == 0 ? Bs : Cs;
#pragma unroll
                    for (int half = 0; half < 2; ++half) {
                        float v[4][4];
                        conv_half<4>(raw, conv_w, conv_b, chan + 4 * half, half, v);
#pragma unroll
                        for (int k = 0; k < 4; ++k) { u32x2 w; w.x = cvt_pk_bf16(v[k][0], v[k][1]); w.y = cvt_pk_bf16(v[k][2], v[k][3]);
                            *(LAS u32x2*)(dst + (l0 + k) * SST + grp * 8 + 4 * half) = w; }
                        if (which == 0) {
#pragma unroll
                            for (int i = 0; i < 4; ++i) { u32x2 w; w.x = cvt_pk_bf16(v[0][i] * wd[0], v[1][i] * wd[1]); w.y = cvt_pk_bf16(v[2][i] * wd[2], v[3][i] * wd[3]);
                                *(LAS u32x2*)(Btw + (grp * 8 + 4 * half + i) * SST + l0) = w; }
                        }
                        asm volatile("" ::: "memory");
                    }
                }
            }
            {
                const int grp = tid & 7, l0 = (tid >> 3) * 2;
                const int chan = h * 64 + grp * 8;
                const bf16_t* src = ZX + (size_t)(t0 + l0 - 3) * ZXW + D_INNER + chan;
                u32x4 raw[7];
#pragma unroll
                for (int r = 0; r < 5; ++r) { if (c == 0 && l0 + r < 3) raw[r] = (u32x4){0u, 0u, 0u, 0u}; else raw[r] = *(const u32x4*)(src + (size_t)r * ZXW); }
                raw[5] = (u32x4){0u, 0u, 0u, 0u}; raw[6] = raw[5];
                const float d0 = dts[l0], d1 = dts[l0 + 1];
#pragma unroll
                for (int half = 0; half < 2; ++half) {
                    float v[4][4];
                    conv_half<2>(raw, conv_w, conv_b, chan + 4 * half, half, v);
#pragma unroll
                    for (int i = 0; i < 4; ++i) *(LAS unsigned*)(XDt + (grp * 8 + 4 * half + i) * SST + l0) = cvt_pk_bf16(v[0][i] * d0, v[1][i] * d1);
                    asm volatile("" ::: "memory");
                }
            }
            float zv[4][4];
#pragma unroll
            for (int aa = 0; aa < 4; ++aa)
#pragma unroll
                for (int j = 0; j < 4; ++j) { const int l = 16 * (lh + 2 * aa) + 4 * fq + j; zv[aa][j] = bf2f(ZX[(size_t)(t0 + l) * ZXW + h * 64 + 16 * pt + fr]); }
            if (c > 0 && tid < 128) { const f32x4 p = *(LAS f32x4*)(ssqp + tid * 4); SSQ[(size_t)(t0 - 128 + tid) * 32 + h] = (p[0] + p[1]) + (p[2] + p[3]); }
            __syncthreads();
            f32x4 yacc[4];
#pragma unroll
            for (int aa = 0; aa < 4; ++aa) yacc[aa] = (f32x4){0.f, 0.f, 0.f, 0.f};
#pragma unroll
            for (int ks = 0; ks < 4; ++ks) {
                bf16x8 bop; { const f32x4 s0 = St[2 * ks], s1 = St[2 * ks + 1]; u32x4 w; w.x = cvt_pk_bf16(s0[0], s0[1]); w.y = cvt_pk_bf16(s0[2], s0[3]); w.z = cvt_pk_bf16(s1[0], s1[1]); w.w = cvt_pk_bf16(s1[2], s1[3]); bop = __builtin_bit_cast(bf16x8, w); }
#pragma unroll
                for (int aa = 0; aa < 4; ++aa) { const int lt = lh + 2 * aa; const LAS bf16_t* cp = Cs + (16 * lt + fr) * SST + 32 * ks + 4 * fq;
                    const u32x2 lo = *(const LAS u32x2*)cp, hi = *(const LAS u32x2*)(cp + 16); u32x4 w; w.x = lo.x; w.y = lo.y; w.z = hi.x; w.w = hi.y;
                    yacc[aa] = __builtin_amdgcn_mfma_f32_16x16x32_bf16(__builtin_bit_cast(bf16x8, w), bop, yacc[aa], 0, 0, 0); }
                asm volatile("" ::: "memory");
            }
#pragma unroll
            for (int aa = 0; aa < 4; ++aa)
#pragma unroll
                for (int j = 0; j < 4; ++j) yacc[aa][j] *= __expf(acs[16 * (lh + 2 * aa) + 4 * fq + j]);
            {
                const float dec = __expf(acs_last);
#pragma unroll
                for (int i = 0; i < 8; ++i) St[i] *= dec;
#pragma unroll 1
                for (int ks = 0; ks < 4; ++ks) {
                    const bf16x8 bop = *(const LAS bf16x8*)(XDt + (16 * pt + fr) * SST + 32 * ks + 8 * fq);
#pragma unroll
                    for (int nt = 0; nt < 8; ++nt) { const bf16x8 aop = *(const LAS bf16x8*)(Btw + (16 * nt + fr) * SST + 32 * ks + 8 * fq);
                        St[nt] = __builtin_amdgcn_mfma_f32_16x16x32_bf16(aop, bop, St[nt], 0, 0, 0); }
                    asm volatile("" ::: "memory");
                }
            }
            {
                int e = 0;
                for (int lt = 0; lt < 8; ++lt)
                    for (int i = 0; i <= lt; ++i, ++e) {
                        if ((e & 7) != wave) continue;
                        f32x4 gacc = {0.f, 0.f, 0.f, 0.f};
#pragma unroll
                        for (int ks = 0; ks < 4; ++ks) { const bf16x8 aop = *(const LAS bf16x8*)(Bs + (16 * i + fr) * SST + 32 * ks + 8 * fq), bop = *(const LAS bf16x8*)(Cs + (16 * lt + fr) * SST + 32 * ks + 8 * fq);
                            gacc = __builtin_amdgcn_mfma_f32_16x16x32_bf16(aop, bop, gacc, 0, 0, 0); }
                        const int l = 16 * lt + fr; const float al = acs[l];
                        float mv[4];
#pragma unroll
                        for (int j = 0; j < 4; ++j) { const int s = 16 * i + 4 * fq + j; float v = 0.f;
                            if (s <= l) { v = gacc[j] * __expf(al - acs[s]); if (s == l) v += Dsk / fmaxf(dts[l], 1e-30f); }
                            mv[j] = v; }
                        u32x2 w; w.x = cvt_pk_bf16(mv[0], mv[1]); w.y = cvt_pk_bf16(mv[2], mv[3]);
                        *(LAS u32x2*)(Ms + l * SST + 16 * i + 4 * fq) = w;
                        if (i == lt && (lt & 1) == 0) *(LAS u32x2*)(Ms + l * SST + 16 * (i + 1) + 4 * fq) = (u32x2){0u, 0u};
                    }
            }
            __syncthreads();
#pragma unroll
            for (int aa = 0; aa < 4; ++aa) { const int lt = lh + 2 * aa;
                for (int ks = 0; ks <= (lt >> 1); ++ks) { const bf16x8 aop = *(const LAS bf16x8*)(Ms + (16 * lt + fr) * SST + 32 * ks + 8 * fq), bop = *(const LAS bf16x8*)(XDt + (16 * pt + fr) * SST + 32 * ks + 8 * fq);
                    yacc[aa] = __builtin_amdgcn_mfma_f32_16x16x32_bf16(aop, bop, yacc[aa], 0, 0, 0); } }
#pragma unroll
            for (int aa = 0; aa < 4; ++aa)
#pragma unroll
                for (int j = 0; j < 4; ++j) { const int l = 16 * (lh + 2 * aa) + 4 * fq + j; const float y = yacc[aa][j] * silu_f(zv[aa][j]);
                    ZX[(size_t)(t0 + l) * ZXW + h * 64 + 16 * pt + fr] = (bf16_t)(cvt_pk_bf16(y, 0.f) & 0xffffu);
                    float q = y * y; q += __shfl_xor(q, 1); q += __shfl_xor(q, 2); q += __shfl_xor(q, 4); q += __shfl_xor(q, 8);
                    if (fr == 0) ssqp[l * 4 + pt] = q; }
        }
        __syncthreads();
        if (tid < 128) { const f32x4 p = *(LAS f32x4*)(ssqp + tid * 4); SSQ[(size_t)(b * SEQ + SEQ - 128 + tid) * 32 + h] = (p[0] + p[1]) + (p[2] + p[3]); }
        __syncthreads();
    }
}

__device__ __forceinline__ void gatenorm_phase(CArgs& a, int gtid, int ngt) {
    bf16_t* ZX = (bf16_t*)(a.ws + WS_ZX); const float* SSQ = (const float*)(a.ws + WS_SSQ);
    for (int it = gtid; it < T * 256; it += ngt) {
        const int t = it >> 8, c8 = it & 255, g = c8 >> 6;
        const f32x4 s0 = *(const f32x4*)(SSQ + (size_t)t * 32 + 8 * g), s1 = *(const f32x4*)(SSQ + (size_t)t * 32 + 8 * g + 4);
        const float rstd = rsqrtf(((s0[0] + s0[1]) + (s0[2] + s0[3]) + (s1[0] + s1[1]) + (s1[2] + s1[3])) * (1.f / 512.f) + EPS);
        u32x4* p = (u32x4*)(ZX + (size_t)t * ZXW + c8 * 8); u32x4 v = *p;
        v.x = cvt_pk_bf16(bflo(v.x) * rstd, bfhi(v.x) * rstd); v.y = cvt_pk_bf16(bflo(v.y) * rstd, bfhi(v.y) * rstd);
        v.z = cvt_pk_bf16(bflo(v.z) * rstd, bfhi(v.z) * rstd); v.w = cvt_pk_bf16(bflo(v.w) * rstd, bfhi(v.w) * rstd);
        *p = v;
    }
}

constexpr int AST = 72;
constexpr int L_KS = 0, L_VT = 9216, L_FLG = 18432;
__device__ __forceinline__ void attn_phase(CArgs& a, LAS unsigned char* lds, int tid, int wave, int lane) {
    const bf16_t* KVQ = (const bf16_t*)(a.ws + WS_KVQ); bf16_t* AO = (bf16_t*)(a.ws + WS_AO);
    LAS bf16_t* Ks = (LAS bf16_t*)(lds + L_KS); LAS bf16_t* Vt = (LAS bf16_t*)(lds + L_VT); LAS unsigned* flg = (LAS unsigned*)(lds + L_FLG);
    const int c = lane & 15, quad = lane >> 4;
    constexpr int NQB = SEQ / 128, NUNITS = BATCH * 16 * NQB;
    for (int unit = blockIdx.x; unit < NUNITS; unit += gridDim.x) {
        const int qb = unit % NQB, bh = unit / NQB, h = bh & 15, b = bh >> 4;
        const int qw0 = 128 * qb + 16 * wave;
        const size_t trow = (size_t)b * SEQ;
        bf16x8 qf[2];
#pragma unroll
        for (int ks = 0; ks < 2; ++ks) { u32x4 w = *(const u32x4*)(KVQ + (trow + qw0 + c) * KVQW + 2048 + h * 64 + 32 * ks + 8 * quad);
            w.x = cvt_pk_bf16(bflo(w.x) * 0.125f, bfhi(w.x) * 0.125f); w.y = cvt_pk_bf16(bflo(w.y) * 0.125f, bfhi(w.y) * 0.125f);
            w.z = cvt_pk_bf16(bflo(w.z) * 0.125f, bfhi(w.z) * 0.125f); w.w = cvt_pk_bf16(bflo(w.w) * 0.125f, bfhi(w.w) * 0.125f); qf[ks] = __builtin_bit_cast(bf16x8, w); }
        f32x4 oacc[4];
#pragma unroll
        for (int i = 0; i < 4; ++i) oacc[i] = (f32x4){0.f, 0.f, 0.f, 0.f};
        float carry = 0.f;
        if (tid < 8) flg[tid] = 1u;
        for (int kt = 2 * qb + 1; kt >= 0; --kt) {
            const int tk0 = 64 * kt;
            __syncthreads();
            unsigned alive = 0u;
#pragma unroll
            for (int i = 0; i < 8; ++i) alive |= flg[i];
            if (!alive) break;
            { const int key = tid >> 3, dg = tid & 7; const bf16_t* src = KVQ + (trow + tk0 + key) * KVQW + h * 64 + 8 * dg;
              const u32x4 kv = *(const u32x4*)src, vv = *(const u32x4*)(src + 1024);
              *(LAS u32x4*)(Ks + key * AST + 8 * dg) = kv;
              Vt[(8 * dg + 0) * AST + key] = (bf16_t)(vv.x & 0xffffu); Vt[(8 * dg + 1) * AST + key] = (bf16_t)(vv.x >> 16);
              Vt[(8 * dg + 2) * AST + key] = (bf16_t)(vv.y & 0xffffu); Vt[(8 * dg + 3) * AST + key] = (bf16_t)(vv.y >> 16);
              Vt[(8 * dg + 4) * AST + key] = (bf16_t)(vv.z & 0xffffu); Vt[(8 * dg + 5) * AST + key] = (bf16_t)(vv.z >> 16);
              Vt[(8 * dg + 6) * AST + key] = (bf16_t)(vv.w & 0xffffu); Vt[(8 * dg + 7) * AST + key] = (bf16_t)(vv.w >> 16); }
            __syncthreads();
            if (tk0 < qw0 + 15) {
                const int qpos = qw0 + c;
                float z[16];
#pragma unroll
                for (int k16 = 0; k16 < 4; ++k16) {
                    f32x4 sacc = {0.f, 0.f, 0.f, 0.f};
                    const int krow = 16 * (c >> 2) + 4 * k16 + (c & 3);
#pragma unroll
                    for (int ks = 0; ks < 2; ++ks) { const bf16x8 aop = *(const LAS bf16x8*)(Ks + krow * AST + 32 * ks + 8 * quad);
                        sacc = __builtin_amdgcn_mfma_f32_16x16x32_bf16(aop, qf[ks], sacc, 0, 0, 0); }
#pragma unroll
                    for (int j = 0; j < 4; ++j) z[4 * k16 + j] = sacc[j];
                }
                float lm[16], suf = 0.f, later[16];
                const int kbase = tk0 + 16 * quad;
#pragma unroll
                for (int i = 15; i >= 0; --i) { const bool valid = (kbase + i) < qpos; const float sp = softplus_f(z[i]); lm[i] = valid ? -sp : 0.f; later[i] = suf; suf += lm[i]; }
                const float T0 = __shfl(suf, c), T1 = __shfl(suf, c + 16), T2 = __shfl(suf, c + 32), T3 = __shfl(suf, c + 48);
                const float qoff = carry + (quad < 1 ? T1 : 0.f) + (quad < 2 ? T2 : 0.f) + (quad < 3 ? T3 : 0.f);
                carry += (T0 + T1) + (T2 + T3);
                float p[16];
#pragma unroll
                for (int i = 0; i < 16; ++i) { const bool valid = (kbase + i) < qpos; p[i] = valid ? __expf(z[i] + lm[i] + later[i] + qoff) : 0.f; }
#pragma unroll
                for (int s = 0; s < 2; ++s) {
                    u32x4 w; w.x = cvt_pk_bf16(p[8 * s + 0], p[8 * s + 1]); w.y = cvt_pk_bf16(p[8 * s + 2], p[8 * s + 3]); w.z = cvt_pk_bf16(p[8 * s + 4], p[8 * s + 5]); w.w = cvt_pk_bf16(p[8 * s + 6], p[8 * s + 7]);
                    const bf16x8 pa = __builtin_bit_cast(bf16x8, w);
#pragma unroll
                    for (int dt = 0; dt < 4; ++dt) { const bf16x8 bop = *(const LAS bf16x8*)(Vt + (16 * dt + c) * AST + 16 * quad + 8 * s);
                        oacc[dt] = __builtin_amdgcn_mfma_f32_16x16x32_bf16(pa, bop, oacc[dt], 0, 0, 0); }
                }
            }
            const bool my_alive = carry > -104.f;
            const unsigned long long bal = __ballot(my_alive);
            if (lane == 0) flg[wave] = bal != 0ull ? 1u : 0u;
        }
#pragma unroll
        for (int dt = 0; dt < 4; ++dt)
#pragma unroll
            for (int j = 0; j < 4; ++j) AO[(trow + qw0 + 4 * quad + j) * D_MODEL + h * 64 + 16 * dt + c] = (bf16_t)(cvt_pk_bf16(oacc[dt][j], 0.f) & 0xffffu);
        __syncthreads();
    }
}

__device__ __forceinline__ void final_norm(float* X, const float* w, int gw, int NGW, int lane) {
    f32x4 wv[4];
#pragma unroll
    for (int j = 0; j < 4; ++j) wv[j] = ((const f32x4*)w)[lane + 64 * j];
    for (int m = gw; m < T; m += NGW) {
        f32x4* xr = (f32x4*)(X + (size_t)m * D_MODEL) + lane;
        f32x4 v[4]; float s = 0.f;
#pragma unroll
        for (int j = 0; j < 4; ++j) { v[j] = xr[64 * j]; s += (v[j].x * v[j].x + v[j].y * v[j].y) + (v[j].z * v[j].z + v[j].w * v[j].w); }
        const float rstd = rsqrtf(wave_sum(s) * (1.f / D_MODEL) + EPS);
#pragma unroll
        for (int j = 0; j < 4; ++j) xr[64 * j] = v[j] * rstd * wv[j];
    }
}

constexpr int NPHASES = 16;
__device__ __forceinline__ CArgs& fresh_args() {
    CArgs* p = (CArgs*)__builtin_amdgcn_kernarg_segment_ptr();
    asm volatile("" : "+s"(p));
    return *p;
}
__global__ void __launch_bounds__(NTHREADS, 2) yoco_fwd(Args args_unused) {
#define args fresh_args()
    extern __shared__ __attribute__((aligned(16))) unsigned char lds_raw[];
    LAS unsigned char* lds = (LAS unsigned char*)lds_raw;
    const int tid = threadIdx.x, lane = tid & 63, wave = __builtin_amdgcn_readfirstlane(tid >> 6);
    const int G = gridDim.x, gw = blockIdx.x * 8 + wave, NGW = G * 8;
#define ws (args.ws)
#define XN ((bf16_t*)(ws + WS_XN))
#define H (args.out)
    const int lo = args.ph_lo, hi = args.ph_hi;
#ifndef MK_PHMASK
#define MK_PHMASK 0xffff
#endif
#define IN(k) ((((MK_PHMASK) >> ((k) > 11 ? (k) - 7 : (k))) & 1) && lo <= (k) && (k) < hi)
#define SEAM(k) do { if (IN(k) && IN((k) + 1)) cg::this_grid().sync(); } while (0)
    if (IN(0)) { p0_prologue(args, lds, gw, NGW, wave, lane); } SEAM(0);
    if (IN(1)) {
        pg8::Gemm g{XN, (const bf16_t*)(ws + WS_WIN)}; pg8::StaticOrder<T / 256, NIN_PAD / 256> S; S.init(G, blockIdx.x);
        pg8::EpiInProj E{(bf16_t*)(ws + WS_ZX), (float*)(ws + WS_DT), args.in[5]};
        pg8::gemm_phase<pg8::EpiInProj, false, true, 1024, 1024>(lds, g, S, E);
    } SEAM(1);
    if (IN(2)) { ssd_phase(args, lds, tid, wave, lane); } SEAM(2);
    if (IN(3)) { gatenorm_phase(args, blockIdx.x * NTHREADS + tid, G * NTHREADS); } SEAM(3);
    if (IN(4)) {
        pg8::Gemm g{(const bf16_t*)(ws + WS_ZX), (const bf16_t*)(ws + WS_WOUT)}; pg8::StaticOrder<T / 256, 4> S; S.init(G, blockIdx.x);
        pg8::EpiRes E{args.in[0], H};
        pg8::gemm_phase<pg8::EpiRes, false, true, 2048, ZXW>(lds, g, S, E);
    } SEAM(4);
#define FFN_BLOCK(layer, pb) \
    if (IN(pb)) { rms_rows_bf16(H, XN, gw, NGW, lane); } SEAM(pb); \
    if (IN(pb + 1)) { \
        pg8::Gemm g{XN, (const bf16_t*)(ws + WS_WUP) + (size_t)layer * FF2 * 1024}; pg8::StaticOrder<133, 22> S; S.init(G, blockIdx.x); \
        pg8::EpiFfn E{(bf16_t*)(ws + WS_ACT), args.in[18] + (size_t)layer * 3 * FF2, args.in[19] + (size_t)layer * FF2}; \
        pg8::gemm_phase<pg8::EpiFfn, true, true, 1024, 1024>(lds, g, S, E); \
    } SEAM(pb + 1); \
    if (IN(pb + 2)) { \
        pg8::Gemm g{(const bf16_t*)(ws + WS_ACT), (const bf16_t*)(ws + WS_WDN) + (size_t)layer * 1024 * D_FF}; pg8::StaticOrder<T / 256, 4> S; S.init(G, blockIdx.x); \
        pg8::EpiRes E{H, H}; \
        pg8::gemm_phase<pg8::EpiRes, false, true, D_FF, D_FF>(lds, g, S, E); \
    } SEAM(pb + 2);
    FFN_BLOCK(0, 5)
    if (IN(8)) { rms_rows_bf16(H, XN, gw, NGW, lane); } SEAM(8);
    if (IN(9)) {
        pg8::Gemm g{XN, (const bf16_t*)(ws + WS_WKVQ)}; pg8::StaticOrder<T / 256, KVQW / 256> S; S.init(G, blockIdx.x);
        pg8::EpiBf16 E{(bf16_t*)(ws + WS_KVQ), KVQW};
        pg8::gemm_phase<pg8::EpiBf16, false, true, 1024, 1024>(lds, g, S, E);
    } SEAM(9);
    if (IN(10)) { attn_phase(args, lds, tid, wave, lane); } SEAM(10);
    if (IN(11)) {
        pg8::Gemm g{(const bf16_t*)(ws + WS_AO), (const bf16_t*)(ws + WS_WO)}; pg8::StaticOrder<T / 256, 4> S; S.init(G, blockIdx.x);
        pg8::EpiRes E{H, H};
        pg8::gemm_phase<pg8::EpiRes, false, true, 1024, 1024>(lds, g, S, E);
    } SEAM(11);
    FFN_BLOCK(1, 12)
#undef FFN_BLOCK
    if (IN(15)) { final_norm(H, args.in[21], gw, NGW, lane); }
#undef IN
#undef SEAM
#undef ws
#undef XN
#undef H
#undef args
}

#ifndef MK_MULTI
#define MK_MULTI 0
#endif
extern "C" void kernel_launch(void* const* d_in, const int* in_sizes, int n_in, void* d_out, int out_size, void* d_ws, size_t ws_size, hipStream_t stream) {
    static int grid = 0;
    if (grid == 0) {
        if (n_in != 22 || out_size != T * D_MODEL || ws_size < WS_END) { fprintf(stderr, "kernel_launch: unexpected sizes n_in %d out %d ws %zu\n", n_in, out_size, ws_size); grid = -1; return; }
        int dev = 0, cus = 0, per_cu = 0;
        hipGetDevice(&dev); hipDeviceGetAttribute(&cus, hipDeviceAttributeMultiprocessorCount, dev);
        if (hipFuncSetAttribute((const void*)yoco_fwd, hipFuncAttributeMaxDynamicSharedMemorySize, LDS_BYTES) != hipSuccess) { fprintf(stderr, "kernel_launch: hipFuncSetAttribute failed\n"); grid = -1; return; }
        if (hipOccupancyMaxActiveBlocksPerMultiprocessor(&per_cu, (const void*)yoco_fwd, NTHREADS, LDS_BYTES) != hipSuccess || per_cu < 1) per_cu = 1;
        (void)hipGetLastError();
        grid = cus * per_cu;
        fprintf(stderr, "kernel_launch: grid %d (cus %d x %d)\n", grid, cus, per_cu);
    }
    if (grid < 0) return;
    Args a{};
    for (int i = 0; i < 22; ++i) a.in[i] = (const float*)d_in[i];
    a.out = (float*)d_out; a.ws = (unsigned char*)d_ws;
#if MK_MULTI
    for (int p = 0; p < NPHASES; ++p) { a.ph_lo = p; a.ph_hi = p + 1; hipLaunchKernelGGL(yoco_fwd, dim3(grid), dim3(NTHREADS), LDS_BYTES, stream, a); }
#else
    a.ph_lo = 0; a.ph_hi = NPHASES;
    void* kargs[] = {&a};
    hipError_t e = hipLaunchCooperativeKernel((const void*)yoco_fwd, dim3(grid), dim3(NTHREADS), kargs, LDS_BYTES, stream);
    if (e != hipSuccess) fprintf(stderr, "cooperative launch failed: %s (grid %d)\n", hipGetErrorString(e), grid);
#endif
}
```

```cpp
#include <hip/hip_runtime.h>
#include <hip/hip_cooperative_groups.h>
#include <cstdio>
#include <cstdint>
namespace cg = cooperative_groups;
#ifndef MK_PROBE_A
#define MK_PROBE_A -1
#define MK_PROBE_B -1
#endif

#define LAS __attribute__((address_space(3)))
typedef unsigned short bf16_t;
typedef short bf16x8 __attribute__((ext_vector_type(8)));
typedef short bf16x4 __attribute__((ext_vector_type(4)));
typedef float f32x4 __attribute__((ext_vector_type(4)));
typedef unsigned u32x4 __attribute__((ext_vector_type(4)));
typedef unsigned u32x2 __attribute__((ext_vector_type(2)));

constexpr int D_MODEL = 1024, BATCH = 8, SEQ = 4096, T = BATCH * SEQ;
constexpr int D_INNER = 2048, SSM_HEADS = 32, GN = 512, CONV_DIM = 3072, IN_PROJ = 5152;
constexpr int ZXW = 5120;
constexpr int NIN_PAD = 5376;
constexpr int D_FF = 2816, FF2 = 5632;
constexpr int KVQW = 3072;
constexpr float EPS = 1e-6f;

constexpr size_t MiB = 1u << 20;
constexpr size_t WS_WIN = 1 * MiB, WS_WOUT = 12 * MiB, WS_WKVQ = 16 * MiB, WS_WO = 22 * MiB, WS_WUP = 24 * MiB, WS_WDN = 46 * MiB;
constexpr size_t WS_DT = 57 * MiB, WS_SSQ = 61 * MiB, WS_XN = 66 * MiB, WS_BIG = 132 * MiB;
constexpr size_t WS_ZX = WS_BIG;
constexpr size_t WS_ACT = WS_BIG;
constexpr size_t WS_AO = WS_BIG;
constexpr size_t WS_KVQ = 308 * MiB;
constexpr size_t WS_END = 500 * MiB;

constexpr int NTHREADS = 512;
constexpr int LDS_BYTES = 163840;

__device__ __forceinline__ unsigned cvt_pk_bf16(float lo, float hi) { unsigned r; asm volatile("v_cvt_pk_bf16_f32 %0, %1, %2" : "=v"(r) : "v"(lo), "v"(hi)); return r; }
__device__ __forceinline__ float bf2f(unsigned short u) { return __uint_as_float((unsigned)u << 16); }
__device__ __forceinline__ float bflo(unsigned u) { return __uint_as_float(u << 16); }
__device__ __forceinline__ float bfhi(unsigned u) { return __uint_as_float(u & 0xffff0000u); }
__device__ __forceinline__ float wave_sum(float v) {
#pragma unroll
    for (int o = 1; o < 64; o <<= 1) v += __shfl_xor(v, o);
    return v;
}
__device__ __forceinline__ float silu_f(float x) { return x * __builtin_amdgcn_rcpf(1.f + __builtin_amdgcn_exp2f(x * -1.44269504088896f)); }
__device__ __forceinline__ float softplus_f(float x) { return fmaxf(x, 0.f) + log1pf(__expf(-fabsf(x))); }
__device__ __forceinline__ float rot_row(float v, int which) {
    int iv = __builtin_bit_cast(int, v), r;
    if (which == 1) r = __builtin_amdgcn_update_dpp(0, iv, 0x121, 0xf, 0xf, false);
    else r = __builtin_amdgcn_update_dpp(0, iv, 0x122, 0xf, 0xf, false);
    return __builtin_bit_cast(float, r);
}

#define LDS_BARRIER() do { asm volatile("s_waitcnt lgkmcnt(0)" ::: "memory"); __builtin_amdgcn_s_barrier(); asm volatile("" ::: "memory"); } while (0)
__device__ __forceinline__ float row_sum16(float v) {
    v += __builtin_bit_cast(float, __builtin_amdgcn_update_dpp(0, __builtin_bit_cast(int, v), 0x128, 0xf, 0xf, false));
    v += __builtin_bit_cast(float, __builtin_amdgcn_update_dpp(0, __builtin_bit_cast(int, v), 0x124, 0xf, 0xf, false));
    v += __builtin_bit_cast(float, __builtin_amdgcn_update_dpp(0, __builtin_bit_cast(int, v), 0x122, 0xf, 0xf, false));
    v += __builtin_bit_cast(float, __builtin_amdgcn_update_dpp(0, __builtin_bit_cast(int, v), 0x121, 0xf, 0xf, false));
    return v;
}
__device__ __forceinline__ float shr_row(float cur, float prev, int n) {
    const int ic = __builtin_bit_cast(int, cur), ip = __builtin_bit_cast(int, prev); int r;
    if (n == 1) { const int t = __builtin_amdgcn_update_dpp(0, ip, 0x121, 0xf, 0xf, false); r = __builtin_amdgcn_update_dpp(t, ic, 0x111, 0xf, 0xf, false); }
    else { const int t = __builtin_amdgcn_update_dpp(0, ip, 0x122, 0xf, 0xf, false); r = __builtin_amdgcn_update_dpp(t, ic, 0x112, 0xf, 0xf, false); }
    return __builtin_bit_cast(float, r);
}
namespace pg8 {
constexpr int BM = 256, BK = 64, HALF = 128, HTB = HALF * BK * 2, STAGE_BYTES = 8 * HTB, NXCD = 8, WGM = 8;
__host__ __device__ __forceinline__ int lds_byte(int r, int c) { const int st = (r >> 4) * 2 + (c >> 5), rr = r & 15, cc = c & 31, ob = rr * 64 + cc * 2; return st * 1024 + (ob ^ (((ob >> 9) & 1) << 5)); }
__host__ __device__ __forceinline__ void stage_rc(int b, int& R, int& C) { const int st = b / 1024, sb = b % 1024, swz = sb ^ (((sb >> 9) & 1) << 5); R = (st >> 1) * 16 + swz / 64; C = (st & 1) * 32 + (swz % 64) / 2; }
__host__ __device__ __forceinline__ int perm32(int rho) { const int n = rho >> 4, i = rho & 15; return 8 * (i >> 2) + 4 * n + (i & 3); }

struct Unit { int pm, pn, par; };
struct Gemm { const bf16_t* A; const bf16_t* Bt; const float* ssq; };
constexpr int LDS_TAB = 131072;

template <int nM, int nN>
struct StaticOrder {
    static constexpr int nwg = nM * nN;
    int G, c;
    __device__ void init(int G_, int c_) { G = G_; c = c_; }
    __device__ bool next(int i, Unit& u) const {
        const int L = i * G + c; if (L >= nwg) return false;
        int wgid = L; { constexpr int q = nwg / NXCD, r = nwg % NXCD; const int xcd = wgid % NXCD, off = wgid / NXCD; wgid = (xcd < r ? xcd * (q + 1) : r * (q + 1) + (xcd - r) * q) + off; }
        constexpr int nig = WGM * nN; const int gid = wgid / nig, fm = gid * WGM, gsz = (nM - fm) < WGM ? (nM - fm) : WGM;
        u.pm = fm + ((wgid % nig) % gsz); u.pn = (wgid % nig) / gsz; return true;
    }
};

template <class Epi, bool AMAP62, bool ALIGN_EPI, int K, int lda, bool SEGS = false, class Sched>
__device__ __forceinline__ void gemm_phase(LAS unsigned char* lds, const Gemm g, const Sched& S, const Epi& E) {
    const int tid = threadIdx.x, wid = __builtin_amdgcn_readfirstlane(tid >> 6), lane = tid & 63, wr = wid >> 2, wc = wid & 3, fr = lane & 15, fq = lane >> 4;
    constexpr int nt = K / BK;
    unsigned voffA[2], voffB[2];
#pragma unroll
    for (int i = 0; i < 2; ++i) { int R, C; stage_rc(tid * 16 + i * 8192, R, C); const int Rb = Epi::PERM ? ((R & ~31) + perm32(R & 31)) : R;
        const int Ra = AMAP62 ? (62 * (R >> 6) + (R & 63)) : R;
        voffA[i] = (unsigned)(Ra * lda + C) * 2u; voffB[i] = (unsigned)(Rb * K + C) * 2u; }
    constexpr size_t kstep = (size_t)(BK * 2);
    constexpr size_t hstepA = (size_t)(AMAP62 ? 124 : 128) * lda * 2, tstepA = (size_t)(AMAP62 ? 248 : 256) * lda * 2;
    constexpr size_t hstepB = (size_t)HALF * K * 2, tstepB = 2 * hstepB;
    const char* baseA = (const char*)g.A - (AMAP62 ? (size_t)2 * lda * 2 : (size_t)0);
    const unsigned ldsw = (unsigned)wid * 1024u;
    const int aoff = lds_byte(wr * 64 + fr, fq * 8), boff = lds_byte(wc * 32 + fr, fq * 8);
#define PG8_SA(b, h) (((b) * 2 + (h)) * HTB)
#define PG8_SB(b, h) ((4 + (b) * 2 + (h)) * HTB)
#define PG8_STAGE(bufoff, gbase, voff) do { _Pragma("unroll") for (int _i = 0; _i < 2; ++_i) \
        __builtin_amdgcn_global_load_lds((const unsigned*)((const char*)(gbase) + (voff)[_i]), (LAS unsigned*)(lds + (bufoff) + ldsw + _i * 8192), 16, 0, 0); } while (0)
#define PG8_LDA(dst, b, h) do { _Pragma("unroll") for (int m = 0; m < 4; ++m) _Pragma("unroll") for (int k = 0; k < 2; ++k) dst[m][k] = *(const LAS bf16x8*)(lds + PG8_SA(b, h) + aoff + m * 2048 + k * 1024); } while (0)
#define PG8_LDB(dst, b, h) do { _Pragma("unroll") for (int n = 0; n < 2; ++n) _Pragma("unroll") for (int k = 0; k < 2; ++k) dst[n][k] = *(const LAS bf16x8*)(lds + PG8_SB(b, h) + boff + n * 2048 + k * 1024); } while (0)
#define PG8_MMA(ai, bj, At, Bt) do { __builtin_amdgcn_s_setprio(1); _Pragma("unroll") for (int m = 0; m < 4; ++m) _Pragma("unroll") for (int n = 0; n < 2; ++n) _Pragma("unroll") for (int k = 0; k < 2; ++k) \
        acc[ai][bj][m][n] = __builtin_amdgcn_mfma_f32_16x16x32_bf16(Bt[n][k], At[m][k], acc[ai][bj][m][n], 0, 0, 0); __builtin_amdgcn_s_setprio(0); } while (0)
#define PG8_WAIT_V(n) asm volatile("s_waitcnt vmcnt(" #n ")" ::: "memory")
#define PG8_WAIT_L(n) asm volatile("s_waitcnt lgkmcnt(" #n ")" ::: "memory")
#define PG8_BAR __builtin_amdgcn_s_barrier()
#define PG8_SCHED __builtin_amdgcn_sched_barrier(0)
    Unit cur, nxt; int ui = 0;
    if (!S.next(0, cur)) return;
    cur.par = 0;
    if constexpr (Epi::STAGE) E.stage(lds, cur, tid);
    f32x4 acc[2][2][4][2];
#pragma unroll
    for (int a = 0; a < 2; ++a)
#pragma unroll
        for (int b = 0; b < 2; ++b)
#pragma unroll
            for (int m = 0; m < 4; ++m)
#pragma unroll
                for (int n = 0; n < 2; ++n) acc[a][b][m][n] = (f32x4){0.f, 0.f, 0.f, 0.f};
    bf16x8 At[4][2], B0[2][2], B1[2][2];
    const char* cA = baseA + (size_t)cur.pm * tstepA; const char* cB = (const char*)g.Bt + (size_t)cur.pn * tstepB;
    PG8_STAGE(PG8_SB(0, 0), cB, voffB); PG8_STAGE(PG8_SB(0, 1), cB + hstepB, voffB); PG8_STAGE(PG8_SA(0, 0), cA, voffA); PG8_STAGE(PG8_SA(0, 1), cA + hstepA, voffA);
    if (wr == 1) PG8_BAR;
    PG8_WAIT_V(2); PG8_BAR;
    PG8_STAGE(PG8_SB(1, 0), cB + kstep, voffB); PG8_STAGE(PG8_SA(1, 0), cA + kstep, voffA); PG8_STAGE(PG8_SB(1, 1), cB + hstepB + kstep, voffB);
    PG8_WAIT_V(6); PG8_BAR;
    for (;;) {
        const bool has_next = S.next(ui + 1, nxt); nxt.par = (ui + 1) & 1;
        const char* nA = has_next ? baseA + (size_t)nxt.pm * tstepA : cA; const char* nB = has_next ? (const char*)g.Bt + (size_t)nxt.pn * tstepB : cB;
        for (int t = 0; t < nt; t += 2) {
            const bool last = (t == nt - 2);
            if constexpr (SEGS) {
                if (t == 2 && tid < 256) {
                    const float* sp = g.ssq + (size_t)(cur.pm * 256 + tid) * 32; float r[4];
#pragma unroll
                    for (int q = 0; q < 4; ++q) { const f32x4 a = *(const f32x4*)(sp + 8 * q), b = *(const f32x4*)(sp + 8 * q + 4);
                        r[q] = rsqrtf((((a[0] + a[1]) + (a[2] + a[3])) + ((b[0] + b[1]) + (b[2] + b[3]))) * (1.f / 512.f) + EPS); }
                    *(LAS f32x4*)(lds + LDS_TAB + tid * 16) = (f32x4){r[0] / r[1], r[1] / r[2], r[2] / r[3], r[3]};
                }
                if (t == 8 || t == 16 || t == 24) { const int sidx = (t >> 3) - 1;
#pragma unroll
                    for (int a = 0; a < 2; ++a)
#pragma unroll
                        for (int m = 0; m < 4; ++m) { const float f = *(const LAS float*)(lds + LDS_TAB + (a * HALF + wr * 64 + m * 16 + fr) * 16 + sidx * 4);
#pragma unroll
                            for (int b = 0; b < 2; ++b)
#pragma unroll
                                for (int n = 0; n < 2; ++n) acc[a][b][m][n] *= f; } }
            }
            const char* a1 = cA + (size_t)(t + 1) * kstep;
            const char* a2 = last ? nA : cA + (size_t)(t + 2) * kstep; const char* b2 = last ? nB : cB + (size_t)(t + 2) * kstep;
            const char* a3 = a2 + kstep; const char* b3 = b2 + kstep;
            PG8_LDB(B0, 0, 0); PG8_LDB(B1, 0, 1); PG8_SCHED; PG8_LDA(At, 0, 0); PG8_STAGE(PG8_SA(1, 1), a1 + hstepA, voffA);
            PG8_WAIT_V(8); PG8_WAIT_L(0); PG8_BAR; PG8_MMA(0, 0, At, B0); PG8_MMA(0, 1, At, B1); PG8_BAR; PG8_SCHED;
            PG8_LDA(At, 0, 1); PG8_STAGE(PG8_SB(0, 0), b2, voffB); PG8_STAGE(PG8_SB(0, 1), b2 + hstepB, voffB); PG8_STAGE(PG8_SA(0, 0), a2, voffA);
            PG8_WAIT_V(8); PG8_WAIT_L(0); PG8_BAR; PG8_MMA(1, 0, At, B0); PG8_MMA(1, 1, At, B1); PG8_BAR; PG8_SCHED;
            PG8_LDB(B0, 1, 0); PG8_LDB(B1, 1, 1); PG8_SCHED; PG8_LDA(At, 1, 0); PG8_STAGE(PG8_SA(0, 1), a2 + hstepA, voffA);
            PG8_WAIT_V(8); PG8_WAIT_L(0); PG8_BAR; PG8_MMA(0, 0, At, B0); PG8_MMA(0, 1, At, B1); PG8_BAR; PG8_SCHED;
            PG8_LDA(At, 1, 1); PG8_STAGE(PG8_SB(1, 0), b3, voffB); PG8_STAGE(PG8_SB(1, 1), b3 + hstepB, voffB); PG8_STAGE(PG8_SA(1, 0), a3, voffA);
            PG8_WAIT_V(8); PG8_WAIT_L(0); PG8_BAR; PG8_MMA(1, 0, At, B0); PG8_MMA(1, 1, At, B1); PG8_BAR; PG8_SCHED;
        }
        if constexpr (ALIGN_EPI) { if (wr == 0) PG8_BAR; }
        E(acc, cur, wr, wc, fr, fq);
        if (!has_next) break;
#pragma unroll
        for (int a = 0; a < 2; ++a)
#pragma unroll
            for (int b = 0; b < 2; ++b)
#pragma unroll
                for (int m = 0; m < 4; ++m)
#pragma unroll
                    for (int n = 0; n < 2; ++n) acc[a][b][m][n] = (f32x4){0.f, 0.f, 0.f, 0.f};
        cur = nxt; cA = nA; cB = nB; ++ui;
        if constexpr (Epi::STAGE) E.stage(lds, cur, tid);
        if constexpr (ALIGN_EPI) { if (wr == 1) PG8_BAR; }
    }
    PG8_WAIT_V(0);
    if constexpr (!ALIGN_EPI) { if (wr == 0) PG8_BAR; }
    PG8_BAR;
#undef PG8_SA
#undef PG8_SB
#undef PG8_STAGE
#undef PG8_LDA
#undef PG8_LDB
#undef PG8_MMA
#undef PG8_WAIT_V
#undef PG8_WAIT_L
#undef PG8_BAR
#undef PG8_SCHED
}

__device__ __forceinline__ void rows_rstd(const float* ssqp, const int (&rows)[8], int fq, float (&rs)[8]) {
    f32x4 pv[8];
#pragma unroll
    for (int i = 0; i < 8; ++i) pv[i] = *(const f32x4*)(ssqp + (size_t)rows[i] * 16 + 4 * fq);
#pragma unroll
    for (int i = 0; i < 8; ++i) { float a = (pv[i][0] + pv[i][1]) + (pv[i][2] + pv[i][3]); a += __shfl_xor(a, 16); a += __shfl_xor(a, 32); rs[i] = rsqrtf(a * (1.f / D_MODEL) + EPS); }
}
struct EpiBf16 {
    static constexpr bool PERM = true, STAGE = true;
    bf16_t* O; int ldc; const float* ssqp; const LAS unsigned char* ldsb;
    __device__ __forceinline__ void stage(LAS unsigned char* lds, const Unit& u, int tid) const {
        if (tid < 256) { const f32x4* p = (const f32x4*)(ssqp + (size_t)(u.pm * BM + tid) * 16); const f32x4 a = (p[0] + p[1]) + (p[2] + p[3]);
            *(LAS float*)(lds + LDS_TAB + u.par * 1024 + tid * 4) = rsqrtf(((a[0] + a[1]) + (a[2] + a[3])) * (1.f / D_MODEL) + EPS); }
    }
    __device__ __forceinline__ void operator()(f32x4 (&acc)[2][2][4][2], const Unit& u, int wr, int wc, int fr, int fq) const {
        const int row0 = u.pm * BM + wr * 64 + fr, col0 = u.pn * BM + wc * 32 + 8 * fq;
#pragma unroll
        for (int ai = 0; ai < 2; ++ai)
#pragma unroll
            for (int m = 0; m < 4; ++m) { const int row = row0 + ai * HALF + m * 16; bf16_t* rowp = O + (size_t)row * ldc + col0;
                const float r = *(const LAS float*)(ldsb + LDS_TAB + u.par * 1024 + (ai * HALF + wr * 64 + m * 16 + fr) * 4);
#pragma unroll
                for (int bj = 0; bj < 2; ++bj) { const f32x4 v0 = acc[ai][bj][m][0] * r, v1 = acc[ai][bj][m][1] * r;
                    u32x4 w; w.x = cvt_pk_bf16(v0[0], v0[1]); w.y = cvt_pk_bf16(v0[2], v0[3]); w.z = cvt_pk_bf16(v1[0], v1[1]); w.w = cvt_pk_bf16(v1[2], v1[3]);
                    *(u32x4*)(rowp + bj * HALF) = w; } }
    }
};
struct EpiInProj {
    static constexpr bool PERM = true, STAGE = false;
    bf16_t* ZX;
    __device__ __forceinline__ void operator()(f32x4 (&acc)[2][2][4][2], const Unit& u, int wr, int wc, int fr, int fq) const {
        const int row0 = u.pm * BM + wr * 64 + fr, col0 = u.pn * BM + wc * 32 + 8 * fq;
#pragma unroll
        for (int ai = 0; ai < 2; ++ai)
#pragma unroll
            for (int m = 0; m < 4; ++m) { bf16_t* rowp = ZX + (size_t)(row0 + ai * HALF + m * 16) * ZXW + col0;
#pragma unroll
                for (int bj = 0; bj < 2; ++bj) { const f32x4 v0 = acc[ai][bj][m][0], v1 = acc[ai][bj][m][1];
                    u32x4 w; w.x = cvt_pk_bf16(v0[0], v0[1]); w.y = cvt_pk_bf16(v0[2], v0[3]); w.z = cvt_pk_bf16(v1[0], v1[1]); w.w = cvt_pk_bf16(v1[2], v1[3]);
                    *(u32x4*)(rowp + bj * HALF) = w; } }
    }
};
template <bool BASE_F32, bool SEGS = false>
struct EpiRes {
    static constexpr bool PERM = true, STAGE = false;
    const float* basef; bf16_t* xn; float* ssqp; const LAS unsigned char* ldsb;
    __device__ __forceinline__ void operator()(f32x4 (&acc)[2][2][4][2], const Unit& u, int wr, int wc, int fr, int fq) const {
        const int col0 = u.pn * BM + wc * 32 + 8 * fq;
        if (!BASE_F32) {
            u32x4 hb[2][4][2];
#pragma unroll
            for (int ai = 0; ai < 2; ++ai)
#pragma unroll
                for (int m = 0; m < 4; ++m)
#pragma unroll
                    for (int bj = 0; bj < 2; ++bj) hb[ai][m][bj] = *(const u32x4*)(xn + (size_t)(u.pm * BM + ai * HALF + wr * 64 + m * 16 + fr) * D_MODEL + col0 + bj * HALF);
#pragma unroll
            for (int ai = 0; ai < 2; ++ai)
#pragma unroll
                for (int m = 0; m < 4; ++m) { const int row = u.pm * BM + ai * HALF + wr * 64 + m * 16 + fr; const size_t off = (size_t)row * D_MODEL + col0; float sq = 0.f;
#pragma unroll
                    for (int bj = 0; bj < 2; ++bj) { const u32x4 h = hb[ai][m][bj];
                        const f32x4 o0 = (f32x4){bflo(h.x), bfhi(h.x), bflo(h.y), bfhi(h.y)} + acc[ai][bj][m][0], o1 = (f32x4){bflo(h.z), bfhi(h.z), bflo(h.w), bfhi(h.w)} + acc[ai][bj][m][1];
                        sq += ((o0[0] * o0[0] + o0[1] * o0[1]) + (o0[2] * o0[2] + o0[3] * o0[3])) + ((o1[0] * o1[0] + o1[1] * o1[1]) + (o1[2] * o1[2] + o1[3] * o1[3]));
                        u32x4 w; w.x = cvt_pk_bf16(o0[0], o0[1]); w.y = cvt_pk_bf16(o0[2], o0[3]); w.z = cvt_pk_bf16(o1[0], o1[1]); w.w = cvt_pk_bf16(o1[2], o1[3]);
                        *(u32x4*)(xn + off + bj * HALF) = w; }
                    sq += __shfl_xor(sq, 16); sq += __shfl_xor(sq, 32);
                    if (fq == 0) ssqp[(size_t)row * 16 + u.pn * 4 + wc] = sq; }
        } else {
#pragma unroll
        for (int ai = 0; ai < 2; ++ai)
#pragma unroll
            for (int m = 0; m < 4; ++m) { const int row = u.pm * BM + ai * HALF + wr * 64 + m * 16 + fr; const size_t off = (size_t)row * D_MODEL + col0; float sq = 0.f;
                if (SEGS) { const float f = *(const LAS float*)(ldsb + LDS_TAB + (ai * HALF + wr * 64 + m * 16 + fr) * 16 + 12);
#pragma unroll
                    for (int bj = 0; bj < 2; ++bj) { acc[ai][bj][m][0] *= f; acc[ai][bj][m][1] *= f; } }
#pragma unroll
                for (int bj = 0; bj < 2; ++bj) { const size_t o = off + bj * HALF;
                    const f32x4 b0 = *(const f32x4*)(basef + o), b1 = *(const f32x4*)(basef + o + 4);
                    const f32x4 o0 = b0 + acc[ai][bj][m][0], o1 = b1 + acc[ai][bj][m][1];
                    sq += ((o0[0] * o0[0] + o0[1] * o0[1]) + (o0[2] * o0[2] + o0[3] * o0[3])) + ((o1[0] * o1[0] + o1[1] * o1[1]) + (o1[2] * o1[2] + o1[3] * o1[3]));
                    u32x4 w; w.x = cvt_pk_bf16(o0[0], o0[1]); w.y = cvt_pk_bf16(o0[2], o0[3]); w.z = cvt_pk_bf16(o1[0], o1[1]); w.w = cvt_pk_bf16(o1[2], o1[3]);
                    *(u32x4*)(xn + o) = w; }
                sq += __shfl_xor(sq, 16); sq += __shfl_xor(sq, 32);
                if (fq == 0) ssqp[(size_t)row * 16 + u.pn * 4 + wc] = sq;
                asm volatile("" ::: "memory"); }
        }
    }
};
struct EpiFfn {
    static constexpr bool PERM = true, STAGE = true;
    bf16_t* ACT; const float* cw; const float* cb; const float* ssqp; const LAS unsigned char* ldsb;
    static constexpr int FTAB_R = LDS_TAB, FTAB_W = LDS_TAB + 1024, FTAB_STRIDE = 5120;
    __device__ __forceinline__ void stage(LAS unsigned char* lds, const Unit& u, int tid) const {
        if (tid < 256) { const int kind = tid >> 5, c4 = tid & 31, ch = u.pn * 128 + 4 * c4, k3 = kind & 3;
            const float* src = (k3 < 3 ? cw + k3 * FF2 : cb) + (kind >= 4 ? D_FF : 0) + ch;
            *(LAS f32x4*)(lds + u.par * FTAB_STRIDE + FTAB_W + kind * 512 + c4 * 16) = *(const f32x4*)src;
        } else { const int R = tid - 256; int t = u.pm * 248 + 62 * (R >> 6) - 2 + (R & 63); t = t < 0 ? 0 : (t >= T ? T - 1 : t);
            const f32x4* p = (const f32x4*)(ssqp + (size_t)t * 16); const f32x4 a = (p[0] + p[1]) + (p[2] + p[3]);
            *(LAS float*)(lds + u.par * FTAB_STRIDE + FTAB_R + R * 4) = rsqrtf(((a[0] + a[1]) + (a[2] + a[3])) * (1.f / D_MODEL) + EPS); }
    }
    __device__ __forceinline__ void operator()(f32x4 (&acc)[2][2][4][2], const Unit& u, int wr, int wc, int fr, int fq) const {
#pragma unroll
        for (int ai = 0; ai < 2; ++ai)
#pragma unroll
            for (int m = 0; m < 4; ++m) { const float r = *(const LAS float*)(ldsb + u.par * FTAB_STRIDE + FTAB_R + (ai * HALF + wr * 64 + m * 16 + fr) * 4);
#pragma unroll
                for (int bj = 0; bj < 2; ++bj)
#pragma unroll
                    for (int n = 0; n < 2; ++n) acc[ai][bj][m][n] *= r; }
#pragma unroll
        for (int n = 0; n < 2; ++n) {
            const int ch = u.pn * 128 + wc * 32 + 8 * fq + 4 * n;
            const LAS unsigned char* wp = ldsb + u.par * FTAB_STRIDE + FTAB_W + (wc * 32 + 8 * fq + 4 * n) * 4;
            const f32x4 gw0 = *(const LAS f32x4*)(wp), gw1 = *(const LAS f32x4*)(wp + 512), gw2 = *(const LAS f32x4*)(wp + 1024), gb = *(const LAS f32x4*)(wp + 1536);
            const f32x4 vw0 = *(const LAS f32x4*)(wp + 2048), vw1 = *(const LAS f32x4*)(wp + 2560), vw2 = *(const LAS f32x4*)(wp + 3072), vb = *(const LAS f32x4*)(wp + 3584);
#pragma unroll
            for (int ai = 0; ai < 2; ++ai) {
                const int trow0 = u.pm * 248 + 62 * (2 * ai + wr) - 2, p0 = trow0 & (SEQ - 1);
                const bool has_start = (p0 >= SEQ - 63) || (p0 <= 1);
#define FFN_ROWS(MASKED) \
                _Pragma("unroll") for (int m = 0; m < 4; ++m) { \
                    const f32x4 xg = acc[ai][0][m][n], xv = acc[ai][1][m][n]; \
                    const f32x4 og = acc[ai][0][m > 0 ? m - 1 : 0][n], ov = acc[ai][1][m > 0 ? m - 1 : 0][n];     \
                    f32x4 g1, g2, v1, v2; \
                    _Pragma("unroll") for (int j = 0; j < 4; ++j) { g1[j] = shr_row(xg[j], og[j], 1); g2[j] = shr_row(xg[j], og[j], 2); v1[j] = shr_row(xv[j], ov[j], 1); v2[j] = shr_row(xv[j], ov[j], 2); } \
                    const int i = 16 * m + fr, t = trow0 + i; \
                    if (MASKED) { const int pos = t & (SEQ - 1); \
                        if (pos == 0) { g1 = (f32x4){0.f, 0.f, 0.f, 0.f}; v1 = g1; } \
                        if (pos <= 1) { g2 = (f32x4){0.f, 0.f, 0.f, 0.f}; v2 = g2; } } \
                    const f32x4 cgv = gb + gw0 * g2 + gw1 * g1 + gw2 * xg, cvv = vb + vw0 * v2 + vw1 * v1 + vw2 * xv; \
                    float a[4]; \
                    _Pragma("unroll") for (int j = 0; j < 4; ++j) a[j] = silu_f(cgv[j]) * cvv[j]; \
                    if (i >= 2 && t < T) { u32x2 w; w.x = cvt_pk_bf16(a[0], a[1]); w.y = cvt_pk_bf16(a[2], a[3]); *(u32x2*)(ACT + (size_t)t * D_FF + ch) = w; } \
                    asm volatile("" ::: "memory"); \
                }
                if (has_start) { FFN_ROWS(true) } else { FFN_ROWS(false) }
#undef FFN_ROWS
            }
        }
    }
};
}

struct Args {
    const float* in[22];
    float* out; unsigned char* ws;
    int ph_lo, ph_hi;
};
typedef const __attribute__((address_space(4))) Args CArgs;

__device__ __forceinline__ void transpose_item(const float* W, int K, int N, bf16_t* WTrow0  , const float* kscale, LAS float* scr, int k0, int n0, int lane) {
    float tv[32];
#pragma unroll
    for (int i = 0; i < 32; ++i) { const int kk = 2 * i + (lane >> 5); tv[i] = W[(size_t)(k0 + kk) * N + n0 + (lane & 31)]; }
    if (kscale) {
#pragma unroll
        for (int i = 0; i < 32; ++i) tv[i] *= kscale[k0 + 2 * i + (lane >> 5)]; }
#pragma unroll
    for (int i = 0; i < 32; ++i) { const int kk = 2 * i + (lane >> 5); scr[kk * 33 + (lane & 31)] = tv[i]; }
    asm volatile("s_waitcnt lgkmcnt(0)" ::: "memory");
    const int c = lane & 7;
#pragma unroll
    for (int j = 0; j < 4; ++j) { const int n = (lane >> 3) + 8 * j; const LAS float* s = scr + (8 * c) * 33 + n;
        u32x4 o; o.x = cvt_pk_bf16(s[0 * 33], s[1 * 33]); o.y = cvt_pk_bf16(s[2 * 33], s[3 * 33]); o.z = cvt_pk_bf16(s[4 * 33], s[5 * 33]); o.w = cvt_pk_bf16(s[6 * 33], s[7 * 33]);
        *(u32x4*)(WTrow0 + (size_t)n * K + k0 + 8 * c) = o; }
    asm volatile("s_waitcnt lgkmcnt(0)" ::: "memory");
}
__device__ __forceinline__ void rms_rows_bf16(const float* X, bf16_t* O, int gw, int NGW, int lane) {
    for (int m = gw; m < T; m += 2 * NGW) {
        const int m1 = m + NGW < T ? m + NGW : m;
        const f32x4* xr0 = (const f32x4*)(X + (size_t)m * D_MODEL) + lane; const f32x4* xr1 = (const f32x4*)(X + (size_t)m1 * D_MODEL) + lane;
        f32x4 v0[4], v1[4]; float s0 = 0.f, s1 = 0.f;
#pragma unroll
        for (int j = 0; j < 4; ++j) { v0[j] = xr0[64 * j]; v1[j] = xr1[64 * j]; }
#pragma unroll
        for (int j = 0; j < 4; ++j) { s0 += (v0[j].x * v0[j].x + v0[j].y * v0[j].y) + (v0[j].z * v0[j].z + v0[j].w * v0[j].w); s1 += (v1[j].x * v1[j].x + v1[j].y * v1[j].y) + (v1[j].z * v1[j].z + v1[j].w * v1[j].w); }
        const float r0 = rsqrtf(wave_sum(s0) * (1.f / D_MODEL) + EPS), r1 = rsqrtf(wave_sum(s1) * (1.f / D_MODEL) + EPS);
        u32x2* o0 = (u32x2*)(O + (size_t)m * D_MODEL) + lane; u32x2* o1 = (u32x2*)(O + (size_t)m1 * D_MODEL) + lane;
#pragma unroll
        for (int j = 0; j < 4; ++j) { u32x2 w; w.x = cvt_pk_bf16(v0[j].x * r0, v0[j].y * r0); w.y = cvt_pk_bf16(v0[j].z * r0, v0[j].w * r0); o0[64 * j] = w; }
        if (m1 != m) {
#pragma unroll
            for (int j = 0; j < 4; ++j) { u32x2 w; w.x = cvt_pk_bf16(v1[j].x * r1, v1[j].y * r1); w.y = cvt_pk_bf16(v1[j].z * r1, v1[j].w * r1); o1[64 * j] = w; } }
    }
}

__device__ __forceinline__ void p0_prologue(CArgs& a, LAS unsigned char* lds, int gw, int NGW, int wave, int lane) {
    LAS float* scr = (LAS float*)(lds + wave * 16384);
    unsigned char* ws = a.ws;
    const float* ssm_norm_w = a.in[1]; const float* ssm_in_w = a.in[2]; const float* gate_norm_w = a.in[8]; const float* ssm_out_w = a.in[9];
    const float* kv_norm_w = a.in[10]; const float* w_k = a.in[11]; const float* w_v = a.in[12]; const float* attn_norm_w = a.in[13]; const float* w_q = a.in[14]; const float* w_o = a.in[15];
    const float* ffn_norm_w = a.in[16]; const float* ffn_up_w = a.in[17]; const float* ffn_down_w = a.in[20];
    bf16_t* WIN = (bf16_t*)(ws + WS_WIN); bf16_t* WOUT = (bf16_t*)(ws + WS_WOUT); bf16_t* WKVQ = (bf16_t*)(ws + WS_WKVQ); bf16_t* WO = (bf16_t*)(ws + WS_WO);
    bf16_t* WUP = (bf16_t*)(ws + WS_WUP); bf16_t* WDN = (bf16_t*)(ws + WS_WDN);
    constexpr int I_IN = 16 * 161, I_OUT = 32 * 32, I_SQ = 16 * 32, I_UP = 16 * 176, I_DN = 44 * 32;
    constexpr int NITEMS = I_IN + I_OUT + 4 * I_SQ + 2 * I_UP + 2 * I_DN;
    for (int it = gw; it < NITEMS; it += NGW) {
        int r = it;
        if (r < I_IN) { const int kb = r / 161, nb = r % 161; transpose_item(ssm_in_w, 1024, IN_PROJ, WIN + (size_t)(32 * nb) * 1024, ssm_norm_w, scr, 64 * kb, 32 * nb, lane); continue; } r -= I_IN;
        if (r < I_OUT) { const int kb = r / 32, nb = r % 32; transpose_item(ssm_out_w, 2048, 1024, WOUT + (size_t)(32 * nb) * 2048, gate_norm_w, scr, 64 * kb, 32 * nb, lane); continue; } r -= I_OUT;
        if (r < I_SQ) { const int kb = r / 32, nb = r % 32; transpose_item(w_k, 1024, 1024, WKVQ + (size_t)(32 * nb) * 1024, kv_norm_w, scr, 64 * kb, 32 * nb, lane); continue; } r -= I_SQ;
        if (r < I_SQ) { const int kb = r / 32, nb = r % 32; transpose_item(w_v, 1024, 1024, WKVQ + (size_t)(1024 + 32 * nb) * 1024, kv_norm_w, scr, 64 * kb, 32 * nb, lane); continue; } r -= I_SQ;
        if (r < I_SQ) { const int kb = r / 32, nb = r % 32; transpose_item(w_q, 1024, 1024, WKVQ + (size_t)(2048 + 32 * nb) * 1024, attn_norm_w, scr, 64 * kb, 32 * nb, lane); continue; } r -= I_SQ;
        if (r < I_SQ) { const int kb = r / 32, nb = r % 32; transpose_item(w_o, 1024, 1024, WO + (size_t)(32 * nb) * 1024, nullptr, scr, 64 * kb, 32 * nb, lane); continue; } r -= I_SQ;
        if (r < 2 * I_UP) { const int l = r / I_UP; r -= l * I_UP; const int kb = r / 176, nb = r % 176; const int n0 = 32 * nb;
            const int drow = n0 < D_FF ? 256 * (n0 / 128) + (n0 % 128) : 256 * ((n0 - D_FF) / 128) + 128 + ((n0 - D_FF) % 128);
            transpose_item(ffn_up_w + (size_t)l * 1024 * FF2, 1024, FF2, WUP + (size_t)l * FF2 * 1024 + (size_t)drow * 1024, ffn_norm_w + l * 1024, scr, 64 * kb, n0, lane); continue; } r -= 2 * I_UP;
        { const int l = r / I_DN; r -= l * I_DN; const int kb = r / 32, nb = r % 32;
            transpose_item(ffn_down_w + (size_t)l * D_FF * 1024, D_FF, 1024, WDN + (size_t)l * 1024 * D_FF + (size_t)(32 * nb) * D_FF, nullptr, scr, 64 * kb, 32 * nb, lane); }
    }
    { u32x4* z = (u32x4*)(WIN + (size_t)IN_PROJ * 1024); const int n16 = 224 * 1024 * 2 / 16;
      for (int i = gw * 64 + lane; i < n16; i += NGW * 64) z[i] = (u32x4){0u, 0u, 0u, 0u}; }
    rms_rows_bf16(a.in[0], (bf16_t*)(ws + WS_XN), gw, NGW, lane);
}

constexpr int SST = 136;
constexpr int L_BS = 0, L_BTW = 34816, L_CS = 69632, L_MS = 104448, L_XDT = 139264, L_ACS = 156672, L_DTS = 157696, L_WDEC = 158720, L_DSK = 159744, L_SSQ = 160768, L_EX = L_BTW + 2048;
static_assert(L_SSQ + 2048 <= LDS_BYTES, "ssd lds");
constexpr size_t WS_BCC = WS_XN;
constexpr size_t WS_SSQP = WS_DT;
constexpr size_t WS_BT = 452 * MiB;

template <int NR>
__device__ __forceinline__ void conv_half(const u32x4 (&raw)[7], const float* cw, const float* cb, int chan4, int half, float (&outv)[4][4]) {
    f32x4 w[4];
#pragma unroll
    for (int j = 0; j < 4; ++j) w[j] = *(const f32x4*)(cw + j * CONV_DIM + chan4);
    const f32x4 b = *(const f32x4*)(cb + chan4);
#pragma unroll
    for (int k = 0; k < NR; ++k)
#pragma unroll
        for (int i = 0; i < 4; ++i) {
            float s = b[i];
#pragma unroll
            for (int j = 0; j < 4; ++j) { const unsigned wd = raw[k + j][2 * half + (i >> 1)]; const float x = (i & 1) ? bfhi(wd) : bflo(wd); s += w[j][i] * x; }
            outv[k][i] = silu_f(s);
        }
}

__device__ __forceinline__ void bcconv_phase(CArgs& a, LAS unsigned char* lds, int tid) {
    const bf16_t* ZX = (const bf16_t*)(a.ws + WS_ZX); bf16_t* BCc = (bf16_t*)(a.ws + WS_BCC);
    const float* conv_w = a.in[3]; const float* conv_b = a.in[4];
    LAS bf16_t* raw = (LAS bf16_t*)lds;
    for (int unit = blockIdx.x; unit < BATCH * 32 * 8; unit += gridDim.x) {
        const int which = unit & 1, g = (unit >> 1) & 3, c = (unit >> 3) & 31, b = unit >> 8;
        const int t0 = b * SEQ + c * 128, cb0 = which * GN + g * 128;
        const bf16_t* src = ZX + (size_t)(t0 - 3) * ZXW + 2 * D_INNER + cb0;
#pragma unroll
        for (int k = 0; k < 5; ++k) { const int idx = tid + 512 * k, row = idx >> 4, c16 = idx & 15;
            if (row < 131) { u32x4 v = (u32x4){0u, 0u, 0u, 0u}; if (!(c == 0 && row < 3)) v = *(const u32x4*)(src + (size_t)row * ZXW + c16 * 8);
                *(LAS u32x4*)(raw + row * SST + c16 * 8) = v; } }
        LDS_BARRIER();
        { const int grp = tid & 15, l0 = (tid >> 4) * 4, chan = D_INNER + cb0 + grp * 8;
          u32x4 rw[7];
#pragma unroll
          for (int r = 0; r < 7; ++r) rw[r] = *(const LAS u32x4*)(raw + (l0 + r) * SST + grp * 8);
          u32x4 outw[4];
#pragma unroll
          for (int half = 0; half < 2; ++half) {
              float v[4][4];
              conv_half<4>(rw, conv_w, conv_b, chan + 4 * half, half, v);
#pragma unroll
              for (int k = 0; k < 4; ++k) { outw[k][2 * half] = cvt_pk_bf16(v[k][0], v[k][1]); outw[k][2 * half + 1] = cvt_pk_bf16(v[k][2], v[k][3]); }
          }
#pragma unroll
          for (int k = 0; k < 4; ++k) *(u32x4*)(BCc + (size_t)(t0 + l0 + k) * 1024 + cb0 + grp * 8) = outw[k];
        }
        LDS_BARRIER();
    }
}

struct SsdRegs { u32x4 b[4], c[4], x[5]; };
__device__ __forceinline__ void ssd_load_bc(SsdRegs& R, const bf16_t* BCc, int b, int g, int chunk, int tid) {
    const int t0 = b * SEQ + chunk * 128, row = tid >> 4, c16 = tid & 15;
#pragma unroll
    for (int k = 0; k < 4; ++k) { const int l = row + 32 * k;
        R.b[k] = *(const u32x4*)(BCc + (size_t)(t0 + l) * 1024 + g * 128 + c16 * 8);
        R.c[k] = *(const u32x4*)(BCc + (size_t)(t0 + l) * 1024 + 512 + g * 128 + c16 * 8); }
}
__device__ __forceinline__ void ssd_load_btx(SsdRegs& R, const bf16_t* BT, const bf16_t* ZX, int b, int g, int h, int chunk, int tid) {
    const int t0 = b * SEQ + chunk * 128; (void)BT; (void)g;
    const int grp = tid & 7, l0 = (tid >> 3) * 2;
    const bf16_t* src = ZX + (size_t)(t0 + l0 - 3) * ZXW + D_INNER + h * 64 + grp * 8;
#pragma unroll
    for (int r = 0; r < 5; ++r) { if (chunk == 0 && l0 + r < 3) R.x[r] = (u32x4){0u, 0u, 0u, 0u}; else R.x[r] = *(const u32x4*)(src + (size_t)r * ZXW); }
}
__device__ __forceinline__ void ssd_scan(LAS unsigned char* lds, int par, float d0, float d1, float Acoef, float Dsk, int lane) {
    LAS float* acs = (LAS float*)(lds + L_ACS + par * 512); LAS float* dts = (LAS float*)(lds + L_DTS + par * 512); LAS float* wdec = (LAS float*)(lds + L_WDEC + par * 512);
    LAS float* dskv = (LAS float*)(lds + L_DSK + par * 512);
    const float a0 = d0 * Acoef, a1 = d1 * Acoef; float s = a0 + a1;
#pragma unroll
    for (int o = 1; o < 64; o <<= 1) { const float n = __shfl_up(s, o); if (lane >= o) s += n; }
    const float last = __shfl(s, 63);
    acs[2 * lane] = s - a1; acs[2 * lane + 1] = s; dts[2 * lane] = d0; dts[2 * lane + 1] = d1;
    wdec[2 * lane] = __expf(last - (s - a1)); wdec[2 * lane + 1] = __expf(last - s);
    dskv[2 * lane] = Dsk / fmaxf(d0, 1e-30f); dskv[2 * lane + 1] = Dsk / fmaxf(d1, 1e-30f);
}

__device__ __forceinline__ void ssd_phase(CArgs& a, LAS unsigned char* lds, int tid, int wave, int lane) {
    unsigned char* ws = a.ws;
    bf16_t* ZX = (bf16_t*)(ws + WS_ZX); const float* DT = (const float*)(ws + WS_DT); float* SSQ = (float*)(ws + WS_SSQ);
    const bf16_t* BCc = (const bf16_t*)(ws + WS_BCC); const bf16_t* BT = (const bf16_t*)(ws + WS_BT);
    const float* conv_w = a.in[3]; const float* conv_b = a.in[4]; const float* a_log = a.in[6]; const float* d_skip = a.in[7];
    const int pt = wave & 3, lh = wave >> 2;
#define SSD_LAUNDER() int vt = tid; asm volatile("" : "+v"(vt)); const int fr = vt & 15, fq = (vt >> 4) & 3; (void)fr; (void)fq
    LAS bf16_t* Bs = (LAS bf16_t*)(lds + L_BS); LAS bf16_t* Btw = (LAS bf16_t*)(lds + L_BTW); LAS bf16_t* Cs = (LAS bf16_t*)(lds + L_CS);
    LAS bf16_t* Ms = (LAS bf16_t*)(lds + L_MS); LAS bf16_t* XDt = (LAS bf16_t*)(lds + L_XDT);
    LAS float* ssqp = (LAS float*)(lds + L_SSQ);
    constexpr float LOG2E = 1.44269504088896f;
    const int vcu_s = (gridDim.x % 8 == 0) ? (int)(blockIdx.x % 8) * (int)(gridDim.x / 8) + (int)(blockIdx.x / 8) : (int)blockIdx.x;
    for (int unit = vcu_s; unit < BATCH * SSM_HEADS; unit += gridDim.x) {
        const int b = unit >> 5, h = unit & 31, g = h >> 3;
        const float Acoef = -__expf(a_log[h]), Dsk = d_skip[h];
        f32x4 St[4];
#pragma unroll
        for (int i = 0; i < 4; ++i) St[i] = (f32x4){0.f, 0.f, 0.f, 0.f};
        { LAS u32x4* ex = (LAS u32x4*)(lds + L_EX) + (wave * 2) * 64 + lane; ex[0] = (u32x4){0u, 0u, 0u, 0u}; ex[64] = (u32x4){0u, 0u, 0u, 0u}; }
        if (tid < 8) { const int chan = h * 64 + tid * 8; LAS f32x4* tp = (LAS f32x4*)(lds + L_BTW) + tid * 10;
#pragma unroll
          for (int half = 0; half < 2; ++half) {
#pragma unroll
              for (int j = 0; j < 4; ++j) tp[half * 5 + j] = *(const f32x4*)(conv_w + j * CONV_DIM + chan + 4 * half);
              tp[half * 5 + 4] = *(const f32x4*)(conv_b + chan + 4 * half); } }
        SsdRegs R;
        ssd_load_bc(R, BCc, b, g, 0, tid); ssd_load_btx(R, BT, ZX, b, g, h, 0, tid);
        float dn0 = 0.f, dn1 = 0.f;
        if (wave == 7) { const int t0 = b * SEQ; ssd_scan(lds, 0, DT[(size_t)(t0 + 2 * lane) * 32 + h], DT[(size_t)(t0 + 2 * lane + 1) * 32 + h], Acoef, Dsk, lane); }
        for (int c = 0; c < SEQ / 128; ++c) {
            const int t0 = b * SEQ + c * 128;
            LAS float* acs = (LAS float*)(lds + L_ACS + (c & 1) * 512); LAS float* dts = (LAS float*)(lds + L_DTS + (c & 1) * 512); LAS float* wdec = (LAS float*)(lds + L_WDEC + (c & 1) * 512);
            LAS float* dskv = (LAS float*)(lds + L_DSK + (c & 1) * 512);
            LDS_BARRIER();
            { SSD_LAUNDER();
            if (wave == 7 && c + 1 < SEQ / 128) { dn0 = DT[(size_t)(t0 + 128 + 2 * (vt & 63)) * 32 + h]; dn1 = DT[(size_t)(t0 + 128 + 2 * (vt & 63) + 1) * 32 + h]; }
            { const int row = vt >> 4, c16 = vt & 15;
#pragma unroll
              for (int k = 0; k < 4; ++k) { const int l = row + 32 * k;
                  *(LAS u32x4*)(Bs + l * SST + c16 * 8) = R.b[k]; *(LAS u32x4*)(Cs + l * SST + c16 * 8) = R.c[k]; } }
            {
                const int grp = vt & 7, l0 = (vt >> 3) * 2;
                const float d0 = dts[l0], d1 = dts[l0 + 1];
                const LAS f32x4* tp = (const LAS f32x4*)(lds + L_BTW) + grp * 10;
#pragma unroll
                for (int half = 0; half < 2; ++half) {
                    f32x4 cwx[2][4], cbx[2];
#pragma unroll
                    for (int j = 0; j < 4; ++j) cwx[half][j] = tp[half * 5 + j];
                    cbx[half] = tp[half * 5 + 4];
#pragma unroll
                    for (int i = 0; i < 4; ++i) {
                        float s0 = cbx[half][i], s1 = s0;
#pragma unroll
                        for (int j = 0; j < 4; ++j) { const unsigned w0 = R.x[j][2 * half + (i >> 1)], w1 = R.x[j + 1][2 * half + (i >> 1)];
                            s0 += cwx[half][j][i] * ((i & 1) ? bfhi(w0) : bflo(w0)); s1 += cwx[half][j][i] * ((i & 1) ? bfhi(w1) : bflo(w1)); }
                        *(LAS unsigned*)(XDt + (grp * 8 + 4 * half + i) * SST + l0) = cvt_pk_bf16(silu_f(s0) * d0, silu_f(s1) * d1);
                    }
                }
            }
            if (c > 0 && vt < 128) { const f32x4 p = *(LAS f32x4*)(ssqp + vt * 4); SSQ[(size_t)(t0 - 128 + vt) * 32 + h] = (p[0] + p[1]) + (p[2] + p[3]); }
            }
            LDS_BARRIER();
            u32x2 zr[4];
            { SSD_LAUNDER(); if (c + 1 < SEQ / 128) ssd_load_bc(R, BCc, b, g, c + 1, vt);
#pragma unroll
              for (int aa = 0; aa < 4; ++aa) zr[aa] = *(const u32x2*)(ZX + (size_t)(t0 + 16 * (lh + 2 * aa) + fr) * ZXW + h * 64 + 16 * pt + 4 * fq);
            }
            f32x4 yacc[4];
#pragma unroll
            for (int aa = 0; aa < 4; ++aa) yacc[aa] = (f32x4){0.f, 0.f, 0.f, 0.f};
            { SSD_LAUNDER();
#pragma unroll
            for (int ks = 0; ks < 4; ++ks) {
                bf16x8 sop;
                if ((ks >> 1) == lh) { const f32x4 s0 = St[2 * (ks & 1)], s1 = St[2 * (ks & 1) + 1]; u32x4 w; w.x = cvt_pk_bf16(s0[0], s0[1]); w.y = cvt_pk_bf16(s0[2], s0[3]); w.z = cvt_pk_bf16(s1[0], s1[1]); w.w = cvt_pk_bf16(s1[2], s1[3]); sop = __builtin_bit_cast(bf16x8, w); }
                else sop = *(const LAS bf16x8*)(lds + L_EX + (((c & 1) * 8 + (wave ^ 4)) * 2 + (ks & 1)) * 1024 + (vt & 63) * 16);
#pragma unroll
                for (int aa = 0; aa < 4; ++aa) { const int lt = lh + 2 * aa; const LAS bf16_t* cp = Cs + (16 * lt + fr) * SST + 32 * ks + 4 * fq;
                    const u32x2 lo = *(const LAS u32x2*)cp, hi = *(const LAS u32x2*)(cp + 16); u32x4 w; w.x = lo.x; w.y = lo.y; w.z = hi.x; w.w = hi.y;
                    yacc[aa] = __builtin_amdgcn_mfma_f32_16x16x32_bf16(sop, __builtin_bit_cast(bf16x8, w), yacc[aa], 0, 0, 0); }
                asm volatile("" ::: "memory");
            }
#pragma unroll
            for (int aa = 0; aa < 4; ++aa) yacc[aa] *= __expf(acs[16 * (lh + 2 * aa) + fr]);
            }
            { SSD_LAUNDER();
                const float dec = __expf(acs[127]);
#pragma unroll
                for (int i = 0; i < 4; ++i) St[i] *= dec;
#pragma unroll 1
                for (int ks = 0; ks < 4; ++ks) {
                    const u32x4 xr = *(const LAS u32x4*)(XDt + (16 * pt + fr) * SST + 32 * ks + 8 * fq);
                    const f32x4 w0 = *(const LAS f32x4*)(wdec + 32 * ks + 8 * fq), w1 = *(const LAS f32x4*)(wdec + 32 * ks + 8 * fq + 4);
                    u32x4 xs; xs.x = cvt_pk_bf16(bflo(xr.x) * w0[0], bfhi(xr.x) * w0[1]); xs.y = cvt_pk_bf16(bflo(xr.y) * w0[2], bfhi(xr.y) * w0[3]);
                    xs.z = cvt_pk_bf16(bflo(xr.z) * w1[0], bfhi(xr.z) * w1[1]); xs.w = cvt_pk_bf16(bflo(xr.w) * w1[2], bfhi(xr.w) * w1[3]);
                    const bf16x8 bop = __builtin_bit_cast(bf16x8, xs);
#pragma unroll
                    for (int j = 0; j < 4; ++j) {
                        LAS bf16x4* tp = (LAS bf16x4*)(Bs + (32 * ks + 8 * fq + (fr >> 2)) * SST + 16 * (4 * lh + j) + 4 * (fr & 3));
                        const bf16x4 t0v = __builtin_amdgcn_ds_read_tr16_b64_v4i16(tp), t1v = __builtin_amdgcn_ds_read_tr16_b64_v4i16((LAS bf16x4*)((LAS bf16_t*)tp + 4 * SST));
                        const bf16x8 aop = {t0v[0], t0v[1], t0v[2], t0v[3], t1v[0], t1v[1], t1v[2], t1v[3]};
                        St[j] = __builtin_amdgcn_mfma_f32_16x16x32_bf16(aop, bop, St[j], 0, 0, 0); }
                    asm volatile("" ::: "memory");
                }
#pragma unroll
                for (int k2 = 0; k2 < 2; ++k2) { const f32x4 s0 = St[2 * k2], s1 = St[2 * k2 + 1]; u32x4 w; w.x = cvt_pk_bf16(s0[0], s0[1]); w.y = cvt_pk_bf16(s0[2], s0[3]); w.z = cvt_pk_bf16(s1[0], s1[1]); w.w = cvt_pk_bf16(s1[2], s1[3]);
                    *(LAS u32x4*)(lds + L_EX + ((((c + 1) & 1) * 8 + wave) * 2 + k2) * 1024 + (vt & 63) * 16) = w; }
            }
            { SSD_LAUNDER();
                int lt = 0, i = wave;
                while (i > lt) { i -= lt + 1; ++lt; }
                while (lt < 8) {
                    f32x4 gacc = {0.f, 0.f, 0.f, 0.f};
#pragma unroll
                    for (int ks = 0; ks < 4; ++ks) { const bf16x8 aop = *(const LAS bf16x8*)(Bs + (16 * i + fr) * SST + 32 * ks + 8 * fq), bop = *(const LAS bf16x8*)(Cs + (16 * lt + fr) * SST + 32 * ks + 8 * fq);
                        gacc = __builtin_amdgcn_mfma_f32_16x16x32_bf16(aop, bop, gacc, 0, 0, 0); }
                    const int l = 16 * lt + fr; const float al = acs[l] * LOG2E;
                    const f32x4 as4 = *(const LAS f32x4*)(acs + 16 * i + 4 * fq);
                    float mv[4];
#pragma unroll
                    for (int j = 0; j < 4; ++j) mv[j] = gacc[j] * __builtin_amdgcn_exp2f(al - as4[j] * LOG2E);
                    if (i == lt) { const float dk = dskv[l];
#pragma unroll
                        for (int j = 0; j < 4; ++j) { const int sr = 4 * fq + j; mv[j] = sr <= fr ? mv[j] : 0.f; if (sr == fr) mv[j] += dk; }
                        if ((lt & 1) == 0) *(LAS u32x2*)(Ms + l * SST + 16 * (i + 1) + 4 * fq) = (u32x2){0u, 0u}; }
                    u32x2 w; w.x = cvt_pk_bf16(mv[0], mv[1]); w.y = cvt_pk_bf16(mv[2], mv[3]);
                    *(LAS u32x2*)(Ms + l * SST + 16 * i + 4 * fq) = w;
                    i += 8; while (lt < 8 && i > lt) { i -= lt + 1; ++lt; }
                }
            }
            { SSD_LAUNDER();
            if (c + 1 < SEQ / 128) ssd_load_btx(R, BT, ZX, b, g, h, c + 1, vt);
            if (wave == 7 && c + 1 < SEQ / 128) ssd_scan(lds, (c + 1) & 1, dn0, dn1, Acoef, Dsk, vt & 63);
            }
            LDS_BARRIER();
            { SSD_LAUNDER();
#pragma unroll
            for (int aa = 0; aa < 4; ++aa) { const int lt = lh + 2 * aa;
                for (int ks = 0; ks <= (lt >> 1); ++ks) { const bf16x8 mop = *(const LAS bf16x8*)(Ms + (16 * lt + fr) * SST + 32 * ks + 8 * fq), xop = *(const LAS bf16x8*)(XDt + (16 * pt + fr) * SST + 32 * ks + 8 * fq);
                    yacc[aa] = __builtin_amdgcn_mfma_f32_16x16x32_bf16(xop, mop, yacc[aa], 0, 0, 0); } }
#pragma unroll
            for (int aa = 0; aa < 4; ++aa) { const int l = 16 * (lh + 2 * aa) + fr;
                const float y0 = yacc[aa][0] * silu_f(bflo(zr[aa].x)), y1 = yacc[aa][1] * silu_f(bfhi(zr[aa].x)), y2 = yacc[aa][2] * silu_f(bflo(zr[aa].y)), y3 = yacc[aa][3] * silu_f(bfhi(zr[aa].y));
                u32x2 w; w.x = cvt_pk_bf16(y0, y1); w.y = cvt_pk_bf16(y2, y3);
                *(u32x2*)(ZX + (size_t)(t0 + l) * ZXW + h * 64 + 16 * pt + 4 * fq) = w;
                float q = (y0 * y0 + y1 * y1) + (y2 * y2 + y3 * y3); q += __shfl_xor(q, 16); q += __shfl_xor(q, 32);
                if (fq == 0) ssqp[l * 4 + pt] = q; }
            }
        }
        LDS_BARRIER();
        if (tid < 128) { const f32x4 p = *(LAS f32x4*)(ssqp + tid * 4); SSQ[(size_t)(b * SEQ + SEQ - 128 + tid) * 32 + h] = (p[0] + p[1]) + (p[2] + p[3]); }
        LDS_BARRIER();
    }
#undef SSD_LAUNDER
}

__device__ __forceinline__ void gatenorm_phase(CArgs& a, int gtid, int ngt) {
    bf16_t* ZX = (bf16_t*)(a.ws + WS_ZX); const float* SSQ = (const float*)(a.ws + WS_SSQ);
    for (int it = gtid; it < T * 256; it += 4 * ngt) {
        u32x4 v[4]; f32x4 s0[4], s1[4]; u32x4* p[4];
#pragma unroll
        for (int k = 0; k < 4; ++k) { int i2 = it + k * ngt; if (i2 >= T * 256) i2 = it; const int t = i2 >> 8, c8 = i2 & 255, g = c8 >> 6;
            p[k] = (u32x4*)(ZX + (size_t)t * ZXW + c8 * 8); v[k] = *p[k];
            s0[k] = *(const f32x4*)(SSQ + (size_t)t * 32 + 8 * g); s1[k] = *(const f32x4*)(SSQ + (size_t)t * 32 + 8 * g + 4); }
#pragma unroll
        for (int k = 0; k < 4; ++k) { if (k > 0 && it + k * ngt >= T * 256) continue;
            const float rstd = rsqrtf(((s0[k][0] + s0[k][1]) + (s0[k][2] + s0[k][3]) + (s1[k][0] + s1[k][1]) + (s1[k][2] + s1[k][3])) * (1.f / 512.f) + EPS);
            u32x4 w = v[k];
            w.x = cvt_pk_bf16(bflo(w.x) * rstd, bfhi(w.x) * rstd); w.y = cvt_pk_bf16(bflo(w.y) * rstd, bfhi(w.y) * rstd);
            w.z = cvt_pk_bf16(bflo(w.z) * rstd, bfhi(w.z) * rstd); w.w = cvt_pk_bf16(bflo(w.w) * rstd, bfhi(w.w) * rstd);
            *p[k] = w; }
    }
}

constexpr int AST = 72;
constexpr int L_KS = 0, L_VT = 9216, L_ABUF = 18432, L_FLG = 36864;
constexpr float ATT_DEAD = -150.1f;
template <bool MASK>
__device__ __forceinline__ void attn_tile(const LAS bf16_t* Ks, const LAS bf16_t* Vt, const bf16x8 (&qf)[2], f32x4 (&oacc)[4], float& carry, int c, int quad, int kbase, int qpos) {
    float z[16];
#pragma unroll
    for (int k16 = 0; k16 < 4; ++k16) {
        f32x4 sacc = {0.f, 0.f, 0.f, 0.f};
        const int krow = 16 * (c >> 2) + 4 * k16 + (c & 3);
#pragma unroll
        for (int ks = 0; ks < 2; ++ks) { const bf16x8 aop = *(const LAS bf16x8*)(Ks + krow * AST + 32 * ks + 8 * quad);
            sacc = __builtin_amdgcn_mfma_f32_16x16x32_bf16(aop, qf[ks], sacc, 0, 0, 0); }
#pragma unroll
        for (int j = 0; j < 4; ++j) z[4 * k16 + j] = sacc[j];
    }
    float ls[16], later[16], suf = 0.f;
#pragma unroll
    for (int i = 15; i >= 0; --i) {
        const float z2 = z[i];
        const float sp = fmaxf(z2, 0.f) + __builtin_amdgcn_logf(1.f + __builtin_amdgcn_exp2f(-fabsf(z2)));
        ls[i] = z2 - sp; later[i] = suf;
        if (MASK) { if ((kbase + i) < qpos) suf -= sp; } else suf -= sp;
    }
    const float T0 = __shfl(suf, c), T1 = __shfl(suf, c + 16), T2 = __shfl(suf, c + 32), T3 = __shfl(suf, c + 48);
    const float qoff = carry + (quad < 1 ? T1 : 0.f) + (quad < 2 ? T2 : 0.f) + (quad < 3 ? T3 : 0.f);
    carry += (T0 + T1) + (T2 + T3);
    float p[16];
#pragma unroll
    for (int i = 0; i < 16; ++i) { float v = __builtin_amdgcn_exp2f(ls[i] + later[i] + qoff); if (MASK) { if (!((kbase + i) < qpos)) v = 0.f; } p[i] = v; }
#pragma unroll
    for (int s = 0; s < 2; ++s) {
        u32x4 w; w.x = cvt_pk_bf16(p[8 * s + 0], p[8 * s + 1]); w.y = cvt_pk_bf16(p[8 * s + 2], p[8 * s + 3]); w.z = cvt_pk_bf16(p[8 * s + 4], p[8 * s + 5]); w.w = cvt_pk_bf16(p[8 * s + 6], p[8 * s + 7]);
        const bf16x8 pa = __builtin_bit_cast(bf16x8, w);
#pragma unroll
        for (int dt = 0; dt < 4; ++dt) { const bf16x8 bop = *(const LAS bf16x8*)(Vt + (16 * dt + c) * AST + 16 * quad + 8 * s);
            oacc[dt] = __builtin_amdgcn_mfma_f32_16x16x32_bf16(pa, bop, oacc[dt], 0, 0, 0); }
    }
}
__device__ __forceinline__ void attn_phase(CArgs& a, LAS unsigned char* lds, int tid, int wave, int lane) {
    const bf16_t* KVQ = (const bf16_t*)(a.ws + WS_KVQ); bf16_t* AO = (bf16_t*)(a.ws + WS_AO);
    LAS unsigned* flg = (LAS unsigned*)(lds + L_FLG);
    const int c = lane & 15, quad = lane >> 4;
    const int lkey = (tid & 31) + 32 * (tid >> 8), ldg = (tid >> 5) & 7;
    constexpr int NQB = SEQ / 128, NUNITS = BATCH * 16 * NQB;
    constexpr float QSC = 0.125f * 1.44269504088896f;
    u32x4 nq0, nq1, nkA, nvA, nkB, nvB;
#define ATT_PRELOAD(UNIT) { const int qb_ = (UNIT) % NQB, bh_ = (UNIT) / NQB, h_ = bh_ & 15, b_ = bh_ >> 4; const size_t tr_ = (size_t)b_ * SEQ; const int kt_ = 2 * qb_ + 1; \
        const bf16_t* qp_ = KVQ + (tr_ + 128 * qb_ + 16 * wave + c) * KVQW + 2048 + h_ * 64 + 8 * quad; nq0 = *(const u32x4*)qp_; nq1 = *(const u32x4*)(qp_ + 32); \
        const bf16_t* s_ = KVQ + (tr_ + lkey) * KVQW + h_ * 64 + 8 * ldg; \
        nkA = *(const u32x4*)(s_ + (size_t)(64 * kt_) * KVQW); nvA = *(const u32x4*)(s_ + (size_t)(64 * kt_) * KVQW + 1024); \
        nkB = *(const u32x4*)(s_ + (size_t)(64 * (kt_ - 1)) * KVQW); nvB = *(const u32x4*)(s_ + (size_t)(64 * (kt_ - 1)) * KVQW + 1024); }
    const int vcu_a = (gridDim.x % 8 == 0) ? (int)(blockIdx.x % 8) * (int)(gridDim.x / 8) + (int)(blockIdx.x / 8) : (int)blockIdx.x;
    if (vcu_a < NUNITS) ATT_PRELOAD(vcu_a)
    for (int unit = vcu_a; unit < NUNITS; unit += gridDim.x) {
        const int qb = unit % NQB, bh = unit / NQB, h = bh & 15, b = bh >> 4;
        const int qw0 = 128 * qb + 16 * wave;
        const size_t trow = (size_t)b * SEQ;
        bf16x8 qf[2];
        { u32x4 w = nq0;
            w.x = cvt_pk_bf16(bflo(w.x) * QSC, bfhi(w.x) * QSC); w.y = cvt_pk_bf16(bflo(w.y) * QSC, bfhi(w.y) * QSC);
            w.z = cvt_pk_bf16(bflo(w.z) * QSC, bfhi(w.z) * QSC); w.w = cvt_pk_bf16(bflo(w.w) * QSC, bfhi(w.w) * QSC); qf[0] = __builtin_bit_cast(bf16x8, w);
            w = nq1;
            w.x = cvt_pk_bf16(bflo(w.x) * QSC, bfhi(w.x) * QSC); w.y = cvt_pk_bf16(bflo(w.y) * QSC, bfhi(w.y) * QSC);
            w.z = cvt_pk_bf16(bflo(w.z) * QSC, bfhi(w.z) * QSC); w.w = cvt_pk_bf16(bflo(w.w) * QSC, bfhi(w.w) * QSC); qf[1] = __builtin_bit_cast(bf16x8, w); }
        f32x4 oacc[4];
#pragma unroll
        for (int i = 0; i < 4; ++i) oacc[i] = (f32x4){0.f, 0.f, 0.f, 0.f};
        float carry = 0.f; bool wave_alive = true;
        if (tid < 16) flg[tid] = 1u;
        int kt = 2 * qb + 1;
        const bf16_t* src0 = KVQ + (trow + lkey) * KVQW + h * 64 + 8 * ldg;
        u32x4 kA = nkA, vA = nvA, kB = nkB, vB = nvB;
        if (unit + (int)gridDim.x < NUNITS) ATT_PRELOAD(unit + (int)gridDim.x)
#define ATT_STEP(KR, VR, ITV) { \
            LAS bf16_t* Ks = (LAS bf16_t*)(lds + ((ITV) & 1) * L_ABUF + L_KS); LAS bf16_t* Vt = (LAS bf16_t*)(lds + ((ITV) & 1) * L_ABUF + L_VT); \
            *(LAS u32x4*)(Ks + lkey * AST + 8 * ldg) = KR; \
            Vt[(8 * ldg + 0) * AST + lkey] = (bf16_t)(VR.x & 0xffffu); Vt[(8 * ldg + 1) * AST + lkey] = (bf16_t)(VR.x >> 16); \
            Vt[(8 * ldg + 2) * AST + lkey] = (bf16_t)(VR.y & 0xffffu); Vt[(8 * ldg + 3) * AST + lkey] = (bf16_t)(VR.y >> 16); \
            Vt[(8 * ldg + 4) * AST + lkey] = (bf16_t)(VR.z & 0xffffu); Vt[(8 * ldg + 5) * AST + lkey] = (bf16_t)(VR.z >> 16); \
            Vt[(8 * ldg + 6) * AST + lkey] = (bf16_t)(VR.w & 0xffffu); Vt[(8 * ldg + 7) * AST + lkey] = (bf16_t)(VR.w >> 16); \
            LDS_BARRIER(); \
            if ((ITV) > 0) { unsigned alive = 0u; \
                _Pragma("unroll") for (int i = 0; i < 8; ++i) alive |= flg[(((ITV) - 1) & 1) * 8 + i]; \
                if (!alive) goto att_done; } \
            if (kt > 1) { KR = *(const u32x4*)(src0 + (size_t)(64 * (kt - 2)) * KVQW); VR = *(const u32x4*)(src0 + (size_t)(64 * (kt - 2)) * KVQW + 1024); }     \
            const int tk0 = 64 * kt; \
            if (wave_alive && tk0 < qw0 + 15) { \
                if (tk0 + 63 >= qw0) attn_tile<true>(Ks, Vt, qf, oacc, carry, c, quad, tk0 + 16 * quad, qw0 + c); \
                else attn_tile<false>(Ks, Vt, qf, oacc, carry, c, quad, tk0 + 16 * quad, qw0 + c); \
                wave_alive = __ballot(carry > ATT_DEAD) != 0ull; \
            } \
            if (lane == 0) flg[((ITV) & 1) * 8 + wave] = wave_alive ? 1u : 0u; \
            if (kt == 0) goto att_done; \
            --kt; }
        for (int it = 0;; it += 2) {
            ATT_STEP(kA, vA, it)
            ATT_STEP(kB, vB, it + 1)
        }
        att_done:;
#undef ATT_STEP
#pragma unroll
        for (int dt = 0; dt < 4; ++dt)
#pragma unroll
            for (int j = 0; j < 4; ++j) AO[(trow + qw0 + 4 * quad + j) * D_MODEL + h * 64 + 16 * dt + c] = (bf16_t)(cvt_pk_bf16(oacc[dt][j], 0.f) & 0xffffu);
        LDS_BARRIER();
    }
#undef ATT_PRELOAD
}

__device__ __forceinline__ void final_norm(const bf16_t* Hb, float* X, const float* w, int gw, int NGW, int lane, int npert) {
    f32x4 wv[4];
#pragma unroll
    for (int j = 0; j < 2; ++j) { wv[2 * j] = *(const f32x4*)(w + 512 * j + lane * 8); wv[2 * j + 1] = *(const f32x4*)(w + 512 * j + lane * 8 + 4); }
    for (int m = gw; m < T; m += NGW) {
        f32x4 v[4]; float s = 0.f;
#pragma unroll
        for (int j = 0; j < 2; ++j) { const u32x4 hb = *(const u32x4*)(Hb + (size_t)m * D_MODEL + 512 * j + lane * 8);
            v[2 * j] = (f32x4){bflo(hb.x), bfhi(hb.x), bflo(hb.y), bfhi(hb.y)}; v[2 * j + 1] = (f32x4){bflo(hb.z), bfhi(hb.z), bflo(hb.w), bfhi(hb.w)}; }
#pragma unroll
        for (int j = 0; j < 4; ++j) s += (v[j].x * v[j].x + v[j].y * v[j].y) + (v[j].z * v[j].z + v[j].w * v[j].w);
        const float rstd = rsqrtf(wave_sum(s) * (1.f / D_MODEL) + EPS);
#pragma unroll
        for (int j = 0; j < 4; ++j) { f32x4 o = v[j] * rstd * wv[j];
            const int fi = m * D_MODEL + 512 * (j >> 1) + lane * 8 + 4 * (j & 1);
            if (npert > 0) {
#pragma unroll
                for (int e = 0; e < 4; ++e) if (fi + e < npert) o[e] += 0.1f; }
            *(f32x4*)(X + fi) = o; }
    }
}

__device__ __forceinline__ void dt_gemm(const bf16_t* XNp, const bf16_t* WdtT  , const float* bias, float* DT, int gw, int NGW, int lane) {
    const int fr = lane & 15, fq = lane >> 4;
    for (int strip = gw; strip < T / 16; strip += NGW) {
        const bf16_t* ap = XNp + (size_t)(strip * 16 + fr) * 1024 + 8 * fq; const bf16_t* bp = WdtT + (size_t)fr * 1024 + 8 * fq;
        f32x4 a0 = {0.f, 0.f, 0.f, 0.f}, a1 = a0;
#pragma unroll 8
        for (int ks = 0; ks < 32; ++ks) { const bf16x8 av = *(const bf16x8*)(ap + 32 * ks), b0 = *(const bf16x8*)(bp + 32 * ks), b1 = *(const bf16x8*)(bp + 16 * 1024 + 32 * ks);
            a0 = __builtin_amdgcn_mfma_f32_16x16x32_bf16(av, b0, a0, 0, 0, 0); a1 = __builtin_amdgcn_mfma_f32_16x16x32_bf16(av, b1, a1, 0, 0, 0); }
        const float bb0 = bias[fr], bb1 = bias[16 + fr];
#pragma unroll
        for (int j = 0; j < 4; ++j) { float* o = DT + (size_t)(strip * 16 + 4 * fq + j) * 32; o[fr] = softplus_f(a0[j] + bb0); o[16 + fr] = softplus_f(a1[j] + bb1); }
    }
}

#define XB_TMO      128
#define XB_XCNT(j)  (256  + 64 * (j))
#define XB_XSUB(j)  (1280 + 64 * (j))
#define XB_XGEN(j)  (2304 + 64 * (j))
#define XB_TOP      3328
#define XB_TOPGEN   3392
#define XCD_BAR_WORDS 3456
#define XB_SPIN_CAP (1u << 22)
constexpr size_t WS_BAR = 65536;
constexpr int L_XB = 163840 - 16;
__device__ __forceinline__ unsigned xb_ld(unsigned* p)              { return __hip_atomic_load(p, __ATOMIC_RELAXED, __HIP_MEMORY_SCOPE_AGENT); }
__device__ __forceinline__ unsigned xb_add(unsigned* p, unsigned v) { return __hip_atomic_fetch_add(p, v, __ATOMIC_RELAXED, __HIP_MEMORY_SCOPE_AGENT); }
__device__ __forceinline__ unsigned xb_xcc_id() { return (unsigned)__builtin_amdgcn_s_getreg((3 << 11) | 20) & 0xFu; }
#define XB_SPIN(cond, bar) do { unsigned _sp = 0; while (cond) { __builtin_amdgcn_s_sleep(1); \
    if ((++_sp & 255u) == 0u) { if (xb_ld(&(bar)[XB_TMO])) break; if (_sp > XB_SPIN_CAP) { atomicAdd(&(bar)[XB_TMO], 1u); break; } } } } while (0)
__device__ __forceinline__ void xcd_barrier_complete(unsigned* bar, unsigned x, unsigned& nloc, unsigned& nx) {
    const unsigned G = gridDim.x * gridDim.y * gridDim.z;
    unsigned sum, cnt, mine, sp = 0u;
    for (;;) {
        sum = 0u; cnt = 0u; mine = 0u;
#pragma unroll
        for (unsigned j = 0; j < 16; ++j) { const unsigned c = xb_ld(&bar[XB_XCNT(j)]); sum += c; cnt += (c > 0u) ? 1u : 0u; mine = (j == x) ? c : mine; }
        if (sum == G) break;
        __builtin_amdgcn_s_sleep(1);
        if ((++sp & 255u) == 0u) { if (xb_ld(&bar[XB_TMO])) break; if (sp > XB_SPIN_CAP) { atomicAdd(&bar[XB_TMO], 1u); break; } }
    }
    nloc = mine > 0u ? mine : 1u; nx = cnt > 0u ? cnt : 1u;
}
__device__ __forceinline__ void xcd_barrier(unsigned* bar, volatile LAS unsigned* st) {
    asm volatile("s_waitcnt vmcnt(0)" ::: "memory");
    __syncthreads();
    if (threadIdx.x == 0) {
        const unsigned x = xb_xcc_id();
        __builtin_amdgcn_s_waitcnt(0);
        unsigned nloc = st[0], nx = st[1];
        if (nloc == 0u) { xcd_barrier_complete(bar, x, nloc, nx); st[0] = nloc; st[1] = nx; }
        const unsigned old = xb_add(&bar[XB_XSUB(x)], 1u);
        const unsigned gen = old / nloc;
        if (old + 1u == (gen + 1u) * nloc) {
            __builtin_amdgcn_fence(__ATOMIC_RELEASE, "agent");
            asm volatile("s_waitcnt vmcnt(0)" ::: "memory");
            const unsigned og = xb_add(&bar[XB_TOP], 1u);
            const unsigned tg = og / nx;
            if (og + 1u == (tg + 1u) * nx) xb_add(&bar[XB_TOPGEN], 1u);
            else XB_SPIN(xb_ld(&bar[XB_TOPGEN]) == tg, bar);
            __builtin_amdgcn_fence(__ATOMIC_ACQUIRE, "agent");
            xb_add(&bar[XB_XGEN(x)], 1u);
            asm volatile("s_waitcnt vmcnt(0)" ::: "memory");
        } else {
            XB_SPIN(xb_ld(&bar[XB_XGEN(x)]) == gen, bar);
            __builtin_amdgcn_fence(__ATOMIC_ACQUIRE, "agent");
            asm volatile("s_waitcnt vmcnt(0)" ::: "memory");
        }
    }
    __syncthreads();
}

constexpr int NPHASES = 13;
__device__ __forceinline__ CArgs& fresh_args() {
    CArgs* p = (CArgs*)__builtin_amdgcn_kernarg_segment_ptr();
    asm volatile("" : "+s"(p));
    return *p;
}
__global__ void __launch_bounds__(NTHREADS, 2) yoco_fwd(Args args_unused) {
#define args fresh_args()
    extern __shared__ __attribute__((aligned(16))) unsigned char lds_raw[];
    LAS unsigned char* lds = (LAS unsigned char*)lds_raw;
    const int tid = threadIdx.x, lane = tid & 63, wave = __builtin_amdgcn_readfirstlane(tid >> 6);
    const int G = gridDim.x, gw = blockIdx.x * 8 + wave, NGW = G * 8;
#define ws (args.ws)
#define XN ((bf16_t*)(ws + WS_XN))
#define H (args.out)
    const int lo = args.ph_lo, hi = args.ph_hi;
#define IN(k) (lo <= (k) && (k) < hi)
#define STAMP(k) do { if (MK_PROBE_A >= 0 && blockIdx.x == 0 && threadIdx.x == 0) ((unsigned long long*)ws)[k] = __builtin_amdgcn_s_memrealtime(); } while (0)
#define SEAM(k) do { if (IN(k) && IN((k) + 1)) xcd_barrier((unsigned*)(ws + WS_BAR), (volatile LAS unsigned*)(lds + L_XB)); STAMP((k) + 1); } while (0)
    if (hi - lo > 1) {
        if (tid < 2) ((volatile LAS unsigned*)(lds + L_XB))[tid] = 0u;
        __syncthreads();
        if (tid == 0) (void)xb_add(&((unsigned*)(ws + WS_BAR))[XB_XCNT(xb_xcc_id())], 1u);
    }
    if (lo < 0) cg::this_grid().sync();
    STAMP(0);
    if (IN(0)) { p0_prologue(args, lds, gw, NGW, wave, lane); } SEAM(0);
    if (IN(1)) {
        pg8::Gemm g{XN, (const bf16_t*)(ws + WS_WIN), nullptr}; pg8::StaticOrder<T / 256, ZXW / 256> S; S.init(G, blockIdx.x);
        pg8::EpiInProj E{(bf16_t*)(ws + WS_ZX)};
        pg8::gemm_phase<pg8::EpiInProj, false, true, 1024, 1024>(lds, g, S, E);
        dt_gemm(XN, (const bf16_t*)(ws + WS_WIN) + (size_t)ZXW * 1024, args.in[5], (float*)(ws + WS_DT), gw, NGW, lane);
    } SEAM(1);
    if (IN(2)) { bcconv_phase(args, lds, tid); } SEAM(2);
    if (IN(3)) { ssd_phase(args, lds, tid, wave, lane); } SEAM(3);
    if (IN(4)) {
        pg8::Gemm g{(const bf16_t*)(ws + WS_ZX), (const bf16_t*)(ws + WS_WOUT), (const float*)(ws + WS_SSQ)}; pg8::StaticOrder<T / 256, 4> S; S.init(G, blockIdx.x);
        pg8::EpiRes<true, true> E{args.in[0], XN, (float*)(ws + WS_SSQP), lds};
        pg8::gemm_phase<pg8::EpiRes<true, true>, false, true, 2048, ZXW, true>(lds, g, S, E);
    } SEAM(4);
#define FFN_BLOCK(layer, pb) \
    if (IN(pb)) { \
        pg8::Gemm g{XN, (const bf16_t*)(ws + WS_WUP) + (size_t)layer * FF2 * 1024, nullptr}; pg8::StaticOrder<133, 22> S; S.init(G, blockIdx.x); \
        pg8::EpiFfn E{(bf16_t*)(ws + WS_ACT), args.in[18] + (size_t)layer * 3 * FF2, args.in[19] + (size_t)layer * FF2, (const float*)(ws + WS_SSQP), lds}; \
        pg8::gemm_phase<pg8::EpiFfn, true, true, 1024, 1024>(lds, g, S, E); \
    } SEAM(pb); \
    if (IN(pb + 1)) { \
        pg8::Gemm g{(const bf16_t*)(ws + WS_ACT), (const bf16_t*)(ws + WS_WDN) + (size_t)layer * 1024 * D_FF, nullptr}; pg8::StaticOrder<T / 256, 4> S; S.init(G, blockIdx.x); \
        pg8::EpiRes<false> E{nullptr, XN, (float*)(ws + WS_SSQP), lds}; \
        pg8::gemm_phase<pg8::EpiRes<false>, false, true, D_FF, D_FF>(lds, g, S, E); \
    } SEAM(pb + 1);
    FFN_BLOCK(0, 5)
    if (IN(7)) {
        pg8::Gemm g{XN, (const bf16_t*)(ws + WS_WKVQ), nullptr}; pg8::StaticOrder<T / 256, KVQW / 256> S; S.init(G, blockIdx.x);
        pg8::EpiBf16 E{(bf16_t*)(ws + WS_KVQ), KVQW, (const float*)(ws + WS_SSQP), lds};
        pg8::gemm_phase<pg8::EpiBf16, false, true, 1024, 1024>(lds, g, S, E);
    } SEAM(7);
    if (IN(8)) { attn_phase(args, lds, tid, wave, lane); } SEAM(8);
    if (IN(9)) {
        pg8::Gemm g{(const bf16_t*)(ws + WS_AO), (const bf16_t*)(ws + WS_WO), nullptr}; pg8::StaticOrder<T / 256, 4> S; S.init(G, blockIdx.x);
        pg8::EpiRes<false> E{nullptr, XN, (float*)(ws + WS_SSQP), lds};
        pg8::gemm_phase<pg8::EpiRes<false>, false, true, 1024, 1024>(lds, g, S, E);
    } SEAM(9);
    FFN_BLOCK(1, 10)
#undef FFN_BLOCK
    if (IN(12)) { int npert = 0; if (MK_PROBE_A >= 0) { const unsigned long long* st = (const unsigned long long*)ws; npert = (int)((st[MK_PROBE_B < 0 ? 0 : MK_PROBE_B] - st[MK_PROBE_A < 0 ? 0 : MK_PROBE_A]) / 10ull); }
        final_norm(XN, H, args.in[21], gw, NGW, lane, npert); }
#undef IN
#undef SEAM
#undef ws
#undef XN
#undef H
#undef args
}

#ifndef MK_MULTI
#define MK_MULTI 0
#endif
extern "C" void kernel_launch(void* const* d_in, const int* in_sizes, int n_in, void* d_out, int out_size, void* d_ws, size_t ws_size, hipStream_t stream) {
    static int grid = 0;
    if (grid == 0) {
        if (n_in != 22 || out_size != T * D_MODEL || ws_size < WS_END) { fprintf(stderr, "kernel_launch: unexpected sizes n_in %d out %d ws %zu\n", n_in, out_size, ws_size); grid = -1; return; }
        int dev = 0, cus = 0, per_cu = 0;
        hipGetDevice(&dev); hipDeviceGetAttribute(&cus, hipDeviceAttributeMultiprocessorCount, dev);
        if (hipFuncSetAttribute((const void*)yoco_fwd, hipFuncAttributeMaxDynamicSharedMemorySize, LDS_BYTES) != hipSuccess) { fprintf(stderr, "kernel_launch: hipFuncSetAttribute failed\n"); grid = -1; return; }
        if (hipOccupancyMaxActiveBlocksPerMultiprocessor(&per_cu, (const void*)yoco_fwd, NTHREADS, LDS_BYTES) != hipSuccess || per_cu < 1) per_cu = 1;
        (void)hipGetLastError();
        grid = cus * per_cu;
        fprintf(stderr, "kernel_launch: grid %d (cus %d x %d)\n", grid, cus, per_cu);
    }
    if (grid < 0) return;
    (void)hipMemsetAsync((char*)d_ws + WS_BAR, 0, 16384, stream);
    Args a{};
    for (int i = 0; i < 22; ++i) a.in[i] = (const float*)d_in[i];
    a.out = (float*)d_out; a.ws = (unsigned char*)d_ws;
#if MK_MULTI
    for (int p = 0; p < NPHASES; ++p) { a.ph_lo = p; a.ph_hi = p + 1; hipLaunchKernelGGL(yoco_fwd, dim3(grid), dim3(NTHREADS), LDS_BYTES, stream, a); }
#else
    a.ph_lo = 0; a.ph_hi = NPHASES;
    void* kargs[] = {&a};
    hipError_t e = hipLaunchCooperativeKernel((const void*)yoco_fwd, dim3(grid), dim3(NTHREADS), kargs, LDS_BYTES, stream);
    if (e != hipSuccess) fprintf(stderr, "cooperative launch failed: %s (grid %d)\n", hipGetErrorString(e), grid);
#endif
}
```

```cpp
#include <hip/hip_runtime.h>
#include <hip/hip_cooperative_groups.h>
#include <cstdio>
#include <cstdint>
namespace cg = cooperative_groups;
#ifndef MK_PROBE_A
#define MK_PROBE_A -1
#define MK_PROBE_B -1
#endif

#define LAS __attribute__((address_space(3)))
typedef unsigned short bf16_t;
typedef short bf16x8 __attribute__((ext_vector_type(8)));
typedef short bf16x4 __attribute__((ext_vector_type(4)));
typedef float f32x4 __attribute__((ext_vector_type(4)));
typedef unsigned u32x4 __attribute__((ext_vector_type(4)));
typedef unsigned u32x2 __attribute__((ext_vector_type(2)));

constexpr int D_MODEL = 1024, BATCH = 8, SEQ = 4096, T = BATCH * SEQ;
constexpr int D_INNER = 2048, SSM_HEADS = 32, GN = 512, CONV_DIM = 3072, IN_PROJ = 5152;
constexpr int ZXW = 5120;
constexpr int NIN_PAD = 5376;
constexpr int D_FF = 2816, FF2 = 5632;
constexpr int KVQW = 3072;
constexpr float EPS = 1e-6f;

constexpr size_t MiB = 1u << 20;
constexpr size_t WS_WIN = 1 * MiB, WS_WOUT = 12 * MiB, WS_WKVQ = 16 * MiB, WS_WO = 22 * MiB, WS_WUP = 24 * MiB, WS_WDN = 46 * MiB;
constexpr size_t WS_DT = 57 * MiB, WS_SSQ = 61 * MiB, WS_XN = 66 * MiB, WS_BIG = 132 * MiB;
constexpr size_t WS_ZX = WS_BIG;
constexpr size_t WS_ACT = WS_BIG;
constexpr size_t WS_AO = WS_BIG;
constexpr size_t WS_KVQ = 308 * MiB;
constexpr size_t WS_END = 500 * MiB;

constexpr int NTHREADS = 512;
constexpr int LDS_BYTES = 163840;

__device__ __forceinline__ unsigned cvt_pk_bf16(float lo, float hi) { unsigned r; asm volatile("v_cvt_pk_bf16_f32 %0, %1, %2" : "=v"(r) : "v"(lo), "v"(hi)); return r; }
__device__ __forceinline__ float bf2f(unsigned short u) { return __uint_as_float((unsigned)u << 16); }
__device__ __forceinline__ float bflo(unsigned u) { return __uint_as_float(u << 16); }
__device__ __forceinline__ float bfhi(unsigned u) { return __uint_as_float(u & 0xffff0000u); }
__device__ __forceinline__ float wave_sum(float v) {
#pragma unroll
    for (int o = 1; o < 64; o <<= 1) v += __shfl_xor(v, o);
    return v;
}
__device__ __forceinline__ float silu_f(float x) { return x * __builtin_amdgcn_rcpf(1.f + __builtin_amdgcn_exp2f(x * -1.44269504088896f)); }
__device__ __forceinline__ float softplus_f(float x) { return fmaxf(x, 0.f) + log1pf(__expf(-fabsf(x))); }
__device__ __forceinline__ float rot_row(float v, int which) {
    int iv = __builtin_bit_cast(int, v), r;
    if (which == 1) r = __builtin_amdgcn_update_dpp(0, iv, 0x121, 0xf, 0xf, false);
    else r = __builtin_amdgcn_update_dpp(0, iv, 0x122, 0xf, 0xf, false);
    return __builtin_bit_cast(float, r);
}

#define LDS_BARRIER() do { asm volatile("s_waitcnt lgkmcnt(0)" ::: "memory"); __builtin_amdgcn_s_barrier(); asm volatile("" ::: "memory"); } while (0)
__device__ __forceinline__ float row_sum16(float v) {
    v += __builtin_bit_cast(float, __builtin_amdgcn_update_dpp(0, __builtin_bit_cast(int, v), 0x128, 0xf, 0xf, false));
    v += __builtin_bit_cast(float, __builtin_amdgcn_update_dpp(0, __builtin_bit_cast(int, v), 0x124, 0xf, 0xf, false));
    v += __builtin_bit_cast(float, __builtin_amdgcn_update_dpp(0, __builtin_bit_cast(int, v), 0x122, 0xf, 0xf, false));
    v += __builtin_bit_cast(float, __builtin_amdgcn_update_dpp(0, __builtin_bit_cast(int, v), 0x121, 0xf, 0xf, false));
    return v;
}
__device__ __forceinline__ float shr_row(float cur, float prev, int n) {
    const int ic = __builtin_bit_cast(int, cur), ip = __builtin_bit_cast(int, prev); int r;
    if (n == 1) { const int t = __builtin_amdgcn_update_dpp(0, ip, 0x121, 0xf, 0xf, false); r = __builtin_amdgcn_update_dpp(t, ic, 0x111, 0xf, 0xf, false); }
    else { const int t = __builtin_amdgcn_update_dpp(0, ip, 0x122, 0xf, 0xf, false); r = __builtin_amdgcn_update_dpp(t, ic, 0x112, 0xf, 0xf, false); }
    return __builtin_bit_cast(float, r);
}
namespace pg8 {
constexpr int BM = 256, BK = 64, HALF = 128, HTB = HALF * BK * 2, STAGE_BYTES = 8 * HTB, NXCD = 8, WGM = 8;
__host__ __device__ __forceinline__ int lds_byte(int r, int c) { const int st = (r >> 4) * 2 + (c >> 5), rr = r & 15, cc = c & 31, ob = rr * 64 + cc * 2; return st * 1024 + (ob ^ (((ob >> 9) & 1) << 5)); }
__host__ __device__ __forceinline__ void stage_rc(int b, int& R, int& C) { const int st = b / 1024, sb = b % 1024, swz = sb ^ (((sb >> 9) & 1) << 5); R = (st >> 1) * 16 + swz / 64; C = (st & 1) * 32 + (swz % 64) / 2; }
__host__ __device__ __forceinline__ int perm32(int rho) { const int n = rho >> 4, i = rho & 15; return 8 * (i >> 2) + 4 * n + (i & 3); }

struct Unit { int pm, pn, par; };
struct Gemm { const bf16_t* A; const bf16_t* Bt; const float* ssq; };
constexpr int LDS_TAB = 131072;

template <int nM, int nN>
struct StaticOrder {
    static constexpr int nwg = nM * nN;
    int G, c;
    __device__ void init(int G_, int c_) { G = G_; c = c_; }
    __device__ bool next(int i, Unit& u) const {
        const int L = i * G + c; if (L >= nwg) return false;
        int wgid = L; { constexpr int q = nwg / NXCD, r = nwg % NXCD; const int xcd = wgid % NXCD, off = wgid / NXCD; wgid = (xcd < r ? xcd * (q + 1) : r * (q + 1) + (xcd - r) * q) + off; }
        constexpr int nig = WGM * nN; const int gid = wgid / nig, fm = gid * WGM, gsz = (nM - fm) < WGM ? (nM - fm) : WGM;
        u.pm = fm + ((wgid % nig) % gsz); u.pn = (wgid % nig) / gsz; return true;
    }
};

template <class Epi, bool AMAP62, bool ALIGN_EPI, int K, int lda, bool SEGS = false, class Sched>
__device__ __forceinline__ void gemm_phase(LAS unsigned char* lds, const Gemm g, const Sched& S, const Epi& E) {
    const int tid = threadIdx.x, wid = __builtin_amdgcn_readfirstlane(tid >> 6), lane = tid & 63, wr = wid >> 2, wc = wid & 3, fr = lane & 15, fq = lane >> 4;
    constexpr int nt = K / BK;
    unsigned voffA[2], voffB[2];
#pragma unroll
    for (int i = 0; i < 2; ++i) { int R, C; stage_rc(tid * 16 + i * 8192, R, C); const int Rb = Epi::PERM ? ((R & ~31) + perm32(R & 31)) : R;
        const int Ra = AMAP62 ? (62 * (R >> 6) + (R & 63)) : R;
        voffA[i] = (unsigned)(Ra * lda + C) * 2u; voffB[i] = (unsigned)(Rb * K + C) * 2u; }
    constexpr size_t kstep = (size_t)(BK * 2);
    constexpr size_t hstepA = (size_t)(AMAP62 ? 124 : 128) * lda * 2, tstepA = (size_t)(AMAP62 ? 248 : 256) * lda * 2;
    constexpr size_t hstepB = (size_t)HALF * K * 2, tstepB = 2 * hstepB;
    const char* baseA = (const char*)g.A - (AMAP62 ? (size_t)2 * lda * 2 : (size_t)0);
    const unsigned ldsw = (unsigned)wid * 1024u;
    const int aoff = lds_byte(wr * 64 + fr, fq * 8), boff = lds_byte(wc * 32 + fr, fq * 8);
#define PG8_SA(b, h) (((b) * 2 + (h)) * HTB)
#define PG8_SB(b, h) ((4 + (b) * 2 + (h)) * HTB)
#define PG8_STAGE(bufoff, gbase, voff) do { _Pragma("unroll") for (int _i = 0; _i < 2; ++_i) \
        __builtin_amdgcn_global_load_lds((const unsigned*)((const char*)(gbase) + (voff)[_i]), (LAS unsigned*)(lds + (bufoff) + ldsw + _i * 8192), 16, 0, 0); } while (0)
#define PG8_LDA(dst, b, h) do { _Pragma("unroll") for (int m = 0; m < 4; ++m) _Pragma("unroll") for (int k = 0; k < 2; ++k) dst[m][k] = *(const LAS bf16x8*)(lds + PG8_SA(b, h) + aoff + m * 2048 + k * 1024); } while (0)
#define PG8_LDB(dst, b, h) do { _Pragma("unroll") for (int n = 0; n < 2; ++n) _Pragma("unroll") for (int k = 0; k < 2; ++k) dst[n][k] = *(const LAS bf16x8*)(lds + PG8_SB(b, h) + boff + n * 2048 + k * 1024); } while (0)
#define PG8_MMA(ai, bj, At, Bt) do { __builtin_amdgcn_s_setprio(1); _Pragma("unroll") for (int m = 0; m < 4; ++m) _Pragma("unroll") for (int n = 0; n < 2; ++n) _Pragma("unroll") for (int k = 0; k < 2; ++k) \
        acc[ai][bj][m][n] = __builtin_amdgcn_mfma_f32_16x16x32_bf16(Bt[n][k], At[m][k], acc[ai][bj][m][n], 0, 0, 0); __builtin_amdgcn_s_setprio(0); } while (0)
#define PG8_WAIT_V(n) asm volatile("s_waitcnt vmcnt(" #n ")" ::: "memory")
#define PG8_WAIT_L(n) asm volatile("s_waitcnt lgkmcnt(" #n ")" ::: "memory")
#define PG8_BAR __builtin_amdgcn_s_barrier()
#define PG8_SCHED __builtin_amdgcn_sched_barrier(0)
    Unit cur, nxt; int ui = 0;
    if (!S.next(0, cur)) return;
    cur.par = 0;
    if constexpr (Epi::STAGE) E.stage(lds, cur, tid);
    f32x4 acc[2][2][4][2];
#pragma unroll
    for (int a = 0; a < 2; ++a)
#pragma unroll
        for (int b = 0; b < 2; ++b)
#pragma unroll
            for (int m = 0; m < 4; ++m)
#pragma unroll
                for (int n = 0; n < 2; ++n) acc[a][b][m][n] = (f32x4){0.f, 0.f, 0.f, 0.f};
    bf16x8 At[4][2], B0[2][2], B1[2][2];
    const char* cA = baseA + (size_t)cur.pm * tstepA; const char* cB = (const char*)g.Bt + (size_t)cur.pn * tstepB;
    PG8_STAGE(PG8_SB(0, 0), cB, voffB); PG8_STAGE(PG8_SB(0, 1), cB + hstepB, voffB); PG8_STAGE(PG8_SA(0, 0), cA, voffA); PG8_STAGE(PG8_SA(0, 1), cA + hstepA, voffA);
    if (wr == 1) PG8_BAR;
    PG8_WAIT_V(2); PG8_BAR;
    PG8_STAGE(PG8_SB(1, 0), cB + kstep, voffB); PG8_STAGE(PG8_SA(1, 0), cA + kstep, voffA); PG8_STAGE(PG8_SB(1, 1), cB + hstepB + kstep, voffB);
    PG8_WAIT_V(6); PG8_BAR;
    for (;;) {
        const bool has_next = S.next(ui + 1, nxt); nxt.par = (ui + 1) & 1;
        const char* nA = has_next ? baseA + (size_t)nxt.pm * tstepA : cA; const char* nB = has_next ? (const char*)g.Bt + (size_t)nxt.pn * tstepB : cB;
        for (int t = 0; t < nt; t += 2) {
            const bool last = (t == nt - 2);
            if constexpr (SEGS) {
                if (t == 2 && tid < 256) {
                    const float* sp = g.ssq + (size_t)(cur.pm * 256 + tid) * 32; float r[4];
#pragma unroll
                    for (int q = 0; q < 4; ++q) { const f32x4 a = *(const f32x4*)(sp + 8 * q), b = *(const f32x4*)(sp + 8 * q + 4);
                        r[q] = rsqrtf((((a[0] + a[1]) + (a[2] + a[3])) + ((b[0] + b[1]) + (b[2] + b[3]))) * (1.f / 512.f) + EPS); }
                    *(LAS f32x4*)(lds + LDS_TAB + tid * 16) = (f32x4){r[0] / r[1], r[1] / r[2], r[2] / r[3], r[3]};
                }
                if (t == 8 || t == 16 || t == 24) { const int sidx = (t >> 3) - 1;
#pragma unroll
                    for (int a = 0; a < 2; ++a)
#pragma unroll
                        for (int m = 0; m < 4; ++m) { const float f = *(const LAS float*)(lds + LDS_TAB + (a * HALF + wr * 64 + m * 16 + fr) * 16 + sidx * 4);
#pragma unroll
                            for (int b = 0; b < 2; ++b)
#pragma unroll
                                for (int n = 0; n < 2; ++n) acc[a][b][m][n] *= f; } }
            }
            const char* a1 = cA + (size_t)(t + 1) * kstep;
            const char* a2 = last ? nA : cA + (size_t)(t + 2) * kstep; const char* b2 = last ? nB : cB + (size_t)(t + 2) * kstep;
            const char* a3 = a2 + kstep; const char* b3 = b2 + kstep;
            PG8_LDB(B0, 0, 0); PG8_LDB(B1, 0, 1); PG8_SCHED; PG8_LDA(At, 0, 0); PG8_STAGE(PG8_SA(1, 1), a1 + hstepA, voffA);
            PG8_WAIT_V(8); PG8_WAIT_L(0); PG8_BAR; PG8_MMA(0, 0, At, B0); PG8_MMA(0, 1, At, B1); PG8_BAR; PG8_SCHED;
            PG8_LDA(At, 0, 1); PG8_STAGE(PG8_SB(0, 0), b2, voffB); PG8_STAGE(PG8_SB(0, 1), b2 + hstepB, voffB); PG8_STAGE(PG8_SA(0, 0), a2, voffA);
            PG8_WAIT_V(8); PG8_WAIT_L(0); PG8_BAR; PG8_MMA(1, 0, At, B0); PG8_MMA(1, 1, At, B1); PG8_BAR; PG8_SCHED;
            PG8_LDB(B0, 1, 0); PG8_LDB(B1, 1, 1); PG8_SCHED; PG8_LDA(At, 1, 0); PG8_STAGE(PG8_SA(0, 1), a2 + hstepA, voffA);
            PG8_WAIT_V(8); PG8_WAIT_L(0); PG8_BAR; PG8_MMA(0, 0, At, B0); PG8_MMA(0, 1, At, B1); PG8_BAR; PG8_SCHED;
            PG8_LDA(At, 1, 1); PG8_STAGE(PG8_SB(1, 0), b3, voffB); PG8_STAGE(PG8_SB(1, 1), b3 + hstepB, voffB); PG8_STAGE(PG8_SA(1, 0), a3, voffA);
            PG8_WAIT_V(8); PG8_WAIT_L(0); PG8_BAR; PG8_MMA(1, 0, At, B0); PG8_MMA(1, 1, At, B1); PG8_BAR; PG8_SCHED;
        }
        if constexpr (ALIGN_EPI) { if (wr == 0) PG8_BAR; }
        E(acc, cur, wr, wc, fr, fq);
        if (!has_next) break;
#pragma unroll
        for (int a = 0; a < 2; ++a)
#pragma unroll
            for (int b = 0; b < 2; ++b)
#pragma unroll
                for (int m = 0; m < 4; ++m)
#pragma unroll
                    for (int n = 0; n < 2; ++n) acc[a][b][m][n] = (f32x4){0.f, 0.f, 0.f, 0.f};
        cur = nxt; cA = nA; cB = nB; ++ui;
        if constexpr (Epi::STAGE) E.stage(lds, cur, tid);
        if constexpr (ALIGN_EPI) { if (wr == 1) PG8_BAR; }
    }
    PG8_WAIT_V(0);
    if constexpr (!ALIGN_EPI) { if (wr == 0) PG8_BAR; }
    PG8_BAR;
#undef PG8_SA
#undef PG8_SB
#undef PG8_STAGE
#undef PG8_LDA
#undef PG8_LDB
#undef PG8_MMA
#undef PG8_WAIT_V
#undef PG8_WAIT_L
#undef PG8_BAR
#undef PG8_SCHED
}

__device__ __forceinline__ void rows_rstd(const float* ssqp, const int (&rows)[8], int fq, float (&rs)[8]) {
    f32x4 pv[8];
#pragma unroll
    for (int i = 0; i < 8; ++i) pv[i] = *(const f32x4*)(ssqp + (size_t)rows[i] * 16 + 4 * fq);
#pragma unroll
    for (int i = 0; i < 8; ++i) { float a = (pv[i][0] + pv[i][1]) + (pv[i][2] + pv[i][3]); a += __shfl_xor(a, 16); a += __shfl_xor(a, 32); rs[i] = rsqrtf(a * (1.f / D_MODEL) + EPS); }
}
struct EpiBf16 {
    static constexpr bool PERM = true, STAGE = true;
    bf16_t* O; int ldc; const float* ssqp; const LAS unsigned char* ldsb;
    __device__ __forceinline__ void stage(LAS unsigned char* lds, const Unit& u, int tid) const {
        if (tid < 256) { const f32x4* p = (const f32x4*)(ssqp + (size_t)(u.pm * BM + tid) * 16); const f32x4 a = (p[0] + p[1]) + (p[2] + p[3]);
            *(LAS float*)(lds + LDS_TAB + u.par * 1024 + tid * 4) = rsqrtf(((a[0] + a[1]) + (a[2] + a[3])) * (1.f / D_MODEL) + EPS); }
    }
    __device__ __forceinline__ void operator()(f32x4 (&acc)[2][2][4][2], const Unit& u, int wr, int wc, int fr, int fq) const {
        const int row0 = u.pm * BM + wr * 64 + fr, col0 = u.pn * BM + wc * 32 + 8 * fq;
#pragma unroll
        for (int ai = 0; ai < 2; ++ai)
#pragma unroll
            for (int m = 0; m < 4; ++m) { const int row = row0 + ai * HALF + m * 16; bf16_t* rowp = O + (size_t)row * ldc + col0;
                const float r = *(const LAS float*)(ldsb + LDS_TAB + u.par * 1024 + (ai * HALF + wr * 64 + m * 16 + fr) * 4);
#pragma unroll
                for (int bj = 0; bj < 2; ++bj) { const f32x4 v0 = acc[ai][bj][m][0] * r, v1 = acc[ai][bj][m][1] * r;
                    u32x4 w; w.x = cvt_pk_bf16(v0[0], v0[1]); w.y = cvt_pk_bf16(v0[2], v0[3]); w.z = cvt_pk_bf16(v1[0], v1[1]); w.w = cvt_pk_bf16(v1[2], v1[3]);
                    *(u32x4*)(rowp + bj * HALF) = w; } }
    }
};
struct EpiInProj {
    static constexpr bool PERM = true, STAGE = false;
    bf16_t* ZX;
    __device__ __forceinline__ void operator()(f32x4 (&acc)[2][2][4][2], const Unit& u, int wr, int wc, int fr, int fq) const {
        const int row0 = u.pm * BM + wr * 64 + fr, col0 = u.pn * BM + wc * 32 + 8 * fq;
#pragma unroll
        for (int ai = 0; ai < 2; ++ai)
#pragma unroll
            for (int m = 0; m < 4; ++m) { bf16_t* rowp = ZX + (size_t)(row0 + ai * HALF + m * 16) * ZXW + col0;
#pragma unroll
                for (int bj = 0; bj < 2; ++bj) { const f32x4 v0 = acc[ai][bj][m][0], v1 = acc[ai][bj][m][1];
                    u32x4 w; w.x = cvt_pk_bf16(v0[0], v0[1]); w.y = cvt_pk_bf16(v0[2], v0[3]); w.z = cvt_pk_bf16(v1[0], v1[1]); w.w = cvt_pk_bf16(v1[2], v1[3]);
                    *(u32x4*)(rowp + bj * HALF) = w; } }
    }
};
template <bool BASE_F32, bool SEGS = false>
struct EpiRes {
    static constexpr bool PERM = true, STAGE = false;
    const float* basef; bf16_t* xn; float* ssqp; const LAS unsigned char* ldsb;
    __device__ __forceinline__ void operator()(f32x4 (&acc)[2][2][4][2], const Unit& u, int wr, int wc, int fr, int fq) const {
        const int col0 = u.pn * BM + wc * 32 + 8 * fq;
        if (!BASE_F32) {
            u32x4 hb[2][4][2];
#pragma unroll
            for (int ai = 0; ai < 2; ++ai)
#pragma unroll
                for (int m = 0; m < 4; ++m)
#pragma unroll
                    for (int bj = 0; bj < 2; ++bj) hb[ai][m][bj] = *(const u32x4*)(xn + (size_t)(u.pm * BM + ai * HALF + wr * 64 + m * 16 + fr) * D_MODEL + col0 + bj * HALF);
#pragma unroll
            for (int ai = 0; ai < 2; ++ai)
#pragma unroll
                for (int m = 0; m < 4; ++m) { const int row = u.pm * BM + ai * HALF + wr * 64 + m * 16 + fr; const size_t off = (size_t)row * D_MODEL + col0; float sq = 0.f;
#pragma unroll
                    for (int bj = 0; bj < 2; ++bj) { const u32x4 h = hb[ai][m][bj];
                        const f32x4 o0 = (f32x4){bflo(h.x), bfhi(h.x), bflo(h.y), bfhi(h.y)} + acc[ai][bj][m][0], o1 = (f32x4){bflo(h.z), bfhi(h.z), bflo(h.w), bfhi(h.w)} + acc[ai][bj][m][1];
                        sq += ((o0[0] * o0[0] + o0[1] * o0[1]) + (o0[2] * o0[2] + o0[3] * o0[3])) + ((o1[0] * o1[0] + o1[1] * o1[1]) + (o1[2] * o1[2] + o1[3] * o1[3]));
                        u32x4 w; w.x = cvt_pk_bf16(o0[0], o0[1]); w.y = cvt_pk_bf16(o0[2], o0[3]); w.z = cvt_pk_bf16(o1[0], o1[1]); w.w = cvt_pk_bf16(o1[2], o1[3]);
                        *(u32x4*)(xn + off + bj * HALF) = w; }
                    sq += __shfl_xor(sq, 16); sq += __shfl_xor(sq, 32);
                    if (fq == 0) ssqp[(size_t)row * 16 + u.pn * 4 + wc] = sq; }
        } else {
#pragma unroll
        for (int ai = 0; ai < 2; ++ai)
#pragma unroll
            for (int m = 0; m < 4; ++m) { const int row = u.pm * BM + ai * HALF + wr * 64 + m * 16 + fr; const size_t off = (size_t)row * D_MODEL + col0; float sq = 0.f;
                if (SEGS) { const float f = *(const LAS float*)(ldsb + LDS_TAB + (ai * HALF + wr * 64 + m * 16 + fr) * 16 + 12);
#pragma unroll
                    for (int bj = 0; bj < 2; ++bj) { acc[ai][bj][m][0] *= f; acc[ai][bj][m][1] *= f; } }
#pragma unroll
                for (int bj = 0; bj < 2; ++bj) { const size_t o = off + bj * HALF;
                    const f32x4 b0 = *(const f32x4*)(basef + o), b1 = *(const f32x4*)(basef + o + 4);
                    const f32x4 o0 = b0 + acc[ai][bj][m][0], o1 = b1 + acc[ai][bj][m][1];
                    sq += ((o0[0] * o0[0] + o0[1] * o0[1]) + (o0[2] * o0[2] + o0[3] * o0[3])) + ((o1[0] * o1[0] + o1[1] * o1[1]) + (o1[2] * o1[2] + o1[3] * o1[3]));
                    u32x4 w; w.x = cvt_pk_bf16(o0[0], o0[1]); w.y = cvt_pk_bf16(o0[2], o0[3]); w.z = cvt_pk_bf16(o1[0], o1[1]); w.w = cvt_pk_bf16(o1[2], o1[3]);
                    *(u32x4*)(xn + o) = w; }
                sq += __shfl_xor(sq, 16); sq += __shfl_xor(sq, 32);
                if (fq == 0) ssqp[(size_t)row * 16 + u.pn * 4 + wc] = sq;
                asm volatile("" ::: "memory"); }
        }
    }
};
struct EpiFfn {
    static constexpr bool PERM = true, STAGE = true;
    bf16_t* ACT; const float* cw; const float* cb; const float* ssqp; const LAS unsigned char* ldsb;
    static constexpr int FTAB_R = LDS_TAB, FTAB_W = LDS_TAB + 1024, FTAB_STRIDE = 5120;
    __device__ __forceinline__ void stage(LAS unsigned char* lds, const Unit& u, int tid) const {
        if (tid < 256) { const int kind = tid >> 5, c4 = tid & 31, ch = u.pn * 128 + 4 * c4, k3 = kind & 3;
            const float* src = (k3 < 3 ? cw + k3 * FF2 : cb) + (kind >= 4 ? D_FF : 0) + ch;
            *(LAS f32x4*)(lds + u.par * FTAB_STRIDE + FTAB_W + kind * 512 + c4 * 16) = *(const f32x4*)src;
        } else { const int R = tid - 256; int t = u.pm * 248 + 62 * (R >> 6) - 2 + (R & 63); t = t < 0 ? 0 : (t >= T ? T - 1 : t);
            const f32x4* p = (const f32x4*)(ssqp + (size_t)t * 16); const f32x4 a = (p[0] + p[1]) + (p[2] + p[3]);
            *(LAS float*)(lds + u.par * FTAB_STRIDE + FTAB_R + R * 4) = rsqrtf(((a[0] + a[1]) + (a[2] + a[3])) * (1.f / D_MODEL) + EPS); }
    }
    __device__ __forceinline__ void operator()(f32x4 (&acc)[2][2][4][2], const Unit& u, int wr, int wc, int fr, int fq) const {
#pragma unroll
        for (int ai = 0; ai < 2; ++ai)
#pragma unroll
            for (int m = 0; m < 4; ++m) { const float r = *(const LAS float*)(ldsb + u.par * FTAB_STRIDE + FTAB_R + (ai * HALF + wr * 64 + m * 16 + fr) * 4);
#pragma unroll
                for (int bj = 0; bj < 2; ++bj)
#pragma unroll
                    for (int n = 0; n < 2; ++n) acc[ai][bj][m][n] *= r; }
#pragma unroll
        for (int n = 0; n < 2; ++n) {
            const int ch = u.pn * 128 + wc * 32 + 8 * fq + 4 * n;
            const LAS unsigned char* wp = ldsb + u.par * FTAB_STRIDE + FTAB_W + (wc * 32 + 8 * fq + 4 * n) * 4;
            const f32x4 gw0 = *(const LAS f32x4*)(wp), gw1 = *(const LAS f32x4*)(wp + 512), gw2 = *(const LAS f32x4*)(wp + 1024), gb = *(const LAS f32x4*)(wp + 1536);
            const f32x4 vw0 = *(const LAS f32x4*)(wp + 2048), vw1 = *(const LAS f32x4*)(wp + 2560), vw2 = *(const LAS f32x4*)(wp + 3072), vb = *(const LAS f32x4*)(wp + 3584);
#pragma unroll
            for (int ai = 0; ai < 2; ++ai) {
                const int trow0 = u.pm * 248 + 62 * (2 * ai + wr) - 2, p0 = trow0 & (SEQ - 1);
                const bool has_start = (p0 >= SEQ - 63) || (p0 <= 1);
#define FFN_ROWS(MASKED) \
                _Pragma("unroll") for (int m = 0; m < 4; ++m) { \
                    const f32x4 xg = acc[ai][0][m][n], xv = acc[ai][1][m][n]; \
                    const f32x4 og = acc[ai][0][m > 0 ? m - 1 : 0][n], ov = acc[ai][1][m > 0 ? m - 1 : 0][n];     \
                    f32x4 g1, g2, v1, v2; \
                    _Pragma("unroll") for (int j = 0; j < 4; ++j) { g1[j] = shr_row(xg[j], og[j], 1); g2[j] = shr_row(xg[j], og[j], 2); v1[j] = shr_row(xv[j], ov[j], 1); v2[j] = shr_row(xv[j], ov[j], 2); } \
                    const int i = 16 * m + fr, t = trow0 + i; \
                    if (MASKED) { const int pos = t & (SEQ - 1); \
                        if (pos == 0) { g1 = (f32x4){0.f, 0.f, 0.f, 0.f}; v1 = g1; } \
                        if (pos <= 1) { g2 = (f32x4){0.f, 0.f, 0.f, 0.f}; v2 = g2; } } \
                    const f32x4 cgv = gb + gw0 * g2 + gw1 * g1 + gw2 * xg, cvv = vb + vw0 * v2 + vw1 * v1 + vw2 * xv; \
                    float a[4]; \
                    _Pragma("unroll") for (int j = 0; j < 4; ++j) a[j] = silu_f(cgv[j]) * cvv[j]; \
                    if (i >= 2 && t < T) { u32x2 w; w.x = cvt_pk_bf16(a[0], a[1]); w.y = cvt_pk_bf16(a[2], a[3]); *(u32x2*)(ACT + (size_t)t * D_FF + ch) = w; } \
                    asm volatile("" ::: "memory"); \
                }
                if (has_start) { FFN_ROWS(true) } else { FFN_ROWS(false) }
#undef FFN_ROWS
            }
        }
    }
};
}

struct Args {
    const float* in[22];
    float* out; unsigned char* ws;
    int ph_lo, ph_hi;
};
typedef const __attribute__((address_space(4))) Args CArgs;

__device__ __forceinline__ void transpose_item(const float* W, int K, int N, bf16_t* WTrow0  , const float* kscale, LAS float* scr, int k0, int n0, int lane) {
    float tv[32];
#pragma unroll
    for (int i = 0; i < 32; ++i) { const int kk = 2 * i + (lane >> 5); tv[i] = W[(size_t)(k0 + kk) * N + n0 + (lane & 31)]; }
    if (kscale) {
#pragma unroll
        for (int i = 0; i < 32; ++i) tv[i] *= kscale[k0 + 2 * i + (lane >> 5)]; }
#pragma unroll
    for (int i = 0; i < 32; ++i) { const int kk = 2 * i + (lane >> 5); scr[kk * 33 + (lane & 31)] = tv[i]; }
    asm volatile("s_waitcnt lgkmcnt(0)" ::: "memory");
    const int c = lane & 7;
#pragma unroll
    for (int j = 0; j < 4; ++j) { const int n = (lane >> 3) + 8 * j; const LAS float* s = scr + (8 * c) * 33 + n;
        u32x4 o; o.x = cvt_pk_bf16(s[0 * 33], s[1 * 33]); o.y = cvt_pk_bf16(s[2 * 33], s[3 * 33]); o.z = cvt_pk_bf16(s[4 * 33], s[5 * 33]); o.w = cvt_pk_bf16(s[6 * 33], s[7 * 33]);
        *(u32x4*)(WTrow0 + (size_t)n * K + k0 + 8 * c) = o; }
    asm volatile("s_waitcnt lgkmcnt(0)" ::: "memory");
}
__device__ __forceinline__ void rms_rows_bf16(const float* X, bf16_t* O, int gw, int NGW, int lane) {
    for (int m = gw; m < T; m += 2 * NGW) {
        const int m1 = m + NGW < T ? m + NGW : m;
        const f32x4* xr0 = (const f32x4*)(X + (size_t)m * D_MODEL) + lane; const f32x4* xr1 = (const f32x4*)(X + (size_t)m1 * D_MODEL) + lane;
        f32x4 v0[4], v1[4]; float s0 = 0.f, s1 = 0.f;
#pragma unroll
        for (int j = 0; j < 4; ++j) { v0[j] = xr0[64 * j]; v1[j] = xr1[64 * j]; }
#pragma unroll
        for (int j = 0; j < 4; ++j) { s0 += (v0[j].x * v0[j].x + v0[j].y * v0[j].y) + (v0[j].z * v0[j].z + v0[j].w * v0[j].w); s1 += (v1[j].x * v1[j].x + v1[j].y * v1[j].y) + (v1[j].z * v1[j].z + v1[j].w * v1[j].w); }
        const float r0 = rsqrtf(wave_sum(s0) * (1.f / D_MODEL) + EPS), r1 = rsqrtf(wave_sum(s1) * (1.f / D_MODEL) + EPS);
        u32x2* o0 = (u32x2*)(O + (size_t)m * D_MODEL) + lane; u32x2* o1 = (u32x2*)(O + (size_t)m1 * D_MODEL) + lane;
#pragma unroll
        for (int j = 0; j < 4; ++j) { u32x2 w; w.x = cvt_pk_bf16(v0[j].x * r0, v0[j].y * r0); w.y = cvt_pk_bf16(v0[j].z * r0, v0[j].w * r0); o0[64 * j] = w; }
        if (m1 != m) {
#pragma unroll
            for (int j = 0; j < 4; ++j) { u32x2 w; w.x = cvt_pk_bf16(v1[j].x * r1, v1[j].y * r1); w.y = cvt_pk_bf16(v1[j].z * r1, v1[j].w * r1); o1[64 * j] = w; } }
    }
}

__device__ __forceinline__ void p0_prologue(CArgs& a, LAS unsigned char* lds, int gw, int NGW, int wave, int lane) {
    LAS float* scr = (LAS float*)(lds + wave * 16384);
    unsigned char* ws = a.ws;
    const float* ssm_norm_w = a.in[1]; const float* ssm_in_w = a.in[2]; const float* gate_norm_w = a.in[8]; const float* ssm_out_w = a.in[9];
    const float* kv_norm_w = a.in[10]; const float* w_k = a.in[11]; const float* w_v = a.in[12]; const float* attn_norm_w = a.in[13]; const float* w_q = a.in[14]; const float* w_o = a.in[15];
    const float* ffn_norm_w = a.in[16]; const float* ffn_up_w = a.in[17]; const float* ffn_down_w = a.in[20];
    bf16_t* WIN = (bf16_t*)(ws + WS_WIN); bf16_t* WOUT = (bf16_t*)(ws + WS_WOUT); bf16_t* WKVQ = (bf16_t*)(ws + WS_WKVQ); bf16_t* WO = (bf16_t*)(ws + WS_WO);
    bf16_t* WUP = (bf16_t*)(ws + WS_WUP); bf16_t* WDN = (bf16_t*)(ws + WS_WDN);
    constexpr int I_IN = 16 * 161, I_OUT = 32 * 32, I_SQ = 16 * 32, I_UP = 16 * 176, I_DN = 44 * 32;
    constexpr int NITEMS = I_IN + I_OUT + 4 * I_SQ + 2 * I_UP + 2 * I_DN;
    for (int it = gw; it < NITEMS; it += NGW) {
        int r = it;
        if (r < I_IN) { const int kb = r / 161, nb = r % 161; transpose_item(ssm_in_w, 1024, IN_PROJ, WIN + (size_t)(32 * nb) * 1024, ssm_norm_w, scr, 64 * kb, 32 * nb, lane); continue; } r -= I_IN;
        if (r < I_OUT) { const int kb = r / 32, nb = r % 32; transpose_item(ssm_out_w, 2048, 1024, WOUT + (size_t)(32 * nb) * 2048, gate_norm_w, scr, 64 * kb, 32 * nb, lane); continue; } r -= I_OUT;
        if (r < I_SQ) { const int kb = r / 32, nb = r % 32; transpose_item(w_k, 1024, 1024, WKVQ + (size_t)(32 * nb) * 1024, kv_norm_w, scr, 64 * kb, 32 * nb, lane); continue; } r -= I_SQ;
        if (r < I_SQ) { const int kb = r / 32, nb = r % 32; transpose_item(w_v, 1024, 1024, WKVQ + (size_t)(1024 + 32 * nb) * 1024, kv_norm_w, scr, 64 * kb, 32 * nb, lane); continue; } r -= I_SQ;
        if (r < I_SQ) { const int kb = r / 32, nb = r % 32; transpose_item(w_q, 1024, 1024, WKVQ + (size_t)(2048 + 32 * nb) * 1024, attn_norm_w, scr, 64 * kb, 32 * nb, lane); continue; } r -= I_SQ;
        if (r < I_SQ) { const int kb = r / 32, nb = r % 32; transpose_item(w_o, 1024, 1024, WO + (size_t)(32 * nb) * 1024, nullptr, scr, 64 * kb, 32 * nb, lane); continue; } r -= I_SQ;
        if (r < 2 * I_UP) { const int l = r / I_UP; r -= l * I_UP; const int kb = r / 176, nb = r % 176; const int n0 = 32 * nb;
            const int drow = n0 < D_FF ? 256 * (n0 / 128) + (n0 % 128) : 256 * ((n0 - D_FF) / 128) + 128 + ((n0 - D_FF) % 128);
            transpose_item(ffn_up_w + (size_t)l * 1024 * FF2, 1024, FF2, WUP + (size_t)l * FF2 * 1024 + (size_t)drow * 1024, ffn_norm_w + l * 1024, scr, 64 * kb, n0, lane); continue; } r -= 2 * I_UP;
        { const int l = r / I_DN; r -= l * I_DN; const int kb = r / 32, nb = r % 32;
            transpose_item(ffn_down_w + (size_t)l * D_FF * 1024, D_FF, 1024, WDN + (size_t)l * 1024 * D_FF + (size_t)(32 * nb) * D_FF, nullptr, scr, 64 * kb, 32 * nb, lane); }
    }
    { u32x4* z = (u32x4*)(WIN + (size_t)IN_PROJ * 1024); const int n16 = 224 * 1024 * 2 / 16;
      for (int i = gw * 64 + lane; i < n16; i += NGW * 64) z[i] = (u32x4){0u, 0u, 0u, 0u}; }
    rms_rows_bf16(a.in[0], (bf16_t*)(ws + WS_XN), gw, NGW, lane);
}

constexpr int SST = 136;
constexpr int L_BS = 0, L_BTW = 34816, L_CS = 69632, L_MS = 104448, L_XDT = 139264, L_ACS = 156672, L_DTS = 157696, L_WDEC = 158720, L_DSK = 159744, L_SSQ = 160768, L_EX = L_BTW + 2048;
static_assert(L_SSQ + 2048 <= LDS_BYTES, "ssd lds");
constexpr size_t WS_BCC = WS_XN;
constexpr size_t WS_SSQP = WS_DT;
constexpr size_t WS_BT = 452 * MiB;

template <int NR>
__device__ __forceinline__ void conv_half(const u32x4 (&raw)[7], const float* cw, const float* cb, int chan4, int half, float (&outv)[4][4]) {
    f32x4 w[4];
#pragma unroll
    for (int j = 0; j < 4; ++j) w[j] = *(const f32x4*)(cw + j * CONV_DIM + chan4);
    const f32x4 b = *(const f32x4*)(cb + chan4);
#pragma unroll
    for (int k = 0; k < NR; ++k)
#pragma unroll
        for (int i = 0; i < 4; ++i) {
            float s = b[i];
#pragma unroll
            for (int j = 0; j < 4; ++j) { const unsigned wd = raw[k + j][2 * half + (i >> 1)]; const float x = (i & 1) ? bfhi(wd) : bflo(wd); s += w[j][i] * x; }
            outv[k][i] = silu_f(s);
        }
}

template <int NR>
__device__ __forceinline__ void conv_half_pre(const u32x4 (&raw)[7], const f32x4 (&w)[5], int half, float (&outv)[4][4]) {
#pragma unroll
    for (int k = 0; k < NR; ++k)
#pragma unroll
        for (int i = 0; i < 4; ++i) {
            float s = w[4][i];
#pragma unroll
            for (int j = 0; j < 4; ++j) { const unsigned wd = raw[k + j][2 * half + (i >> 1)]; const float x = (i & 1) ? bfhi(wd) : bflo(wd); s += w[j][i] * x; }
            outv[k][i] = silu_f(s);
        }
}
__device__ __forceinline__ void bcconv_phase(CArgs& a, LAS unsigned char* lds, int tid) {
    const bf16_t* ZX = (const bf16_t*)(a.ws + WS_ZX); bf16_t* BCc = (bf16_t*)(a.ws + WS_BCC);
    const float* conv_w = a.in[3]; const float* conv_b = a.in[4];
    LAS bf16_t* raw = (LAS bf16_t*)lds;
    for (int unit = blockIdx.x; unit < BATCH * 32 * 8; unit += gridDim.x) {
        const int which = unit & 1, g = (unit >> 1) & 3, c = (unit >> 3) & 31, b = unit >> 8;
        const int t0 = b * SEQ + c * 128, cb0 = which * GN + g * 128;
        const bf16_t* src = ZX + (size_t)(t0 - 3) * ZXW + 2 * D_INNER + cb0;
        f32x4 tw[2][5];
        { const int chan = D_INNER + cb0 + (tid & 15) * 8;
#pragma unroll
          for (int half = 0; half < 2; ++half) {
#pragma unroll
              for (int j = 0; j < 4; ++j) tw[half][j] = *(const f32x4*)(conv_w + j * CONV_DIM + chan + 4 * half);
              tw[half][4] = *(const f32x4*)(conv_b + chan + 4 * half); } }
#pragma unroll
        for (int k = 0; k < 5; ++k) { const int idx = tid + 512 * k, row = idx >> 4, c16 = idx & 15;
            if (row < 131) { u32x4 v = (u32x4){0u, 0u, 0u, 0u}; if (!(c == 0 && row < 3)) v = *(const u32x4*)(src + (size_t)row * ZXW + c16 * 8);
                *(LAS u32x4*)(raw + row * SST + c16 * 8) = v; } }
        LDS_BARRIER();
        { const int grp = tid & 15, l0 = (tid >> 4) * 4, chan = D_INNER + cb0 + grp * 8;
          u32x4 rw[7];
#pragma unroll
          for (int r = 0; r < 7; ++r) rw[r] = *(const LAS u32x4*)(raw + (l0 + r) * SST + grp * 8);
          u32x4 outw[4];
#pragma unroll
          for (int half = 0; half < 2; ++half) {
              float v[4][4];
              conv_half_pre<4>(rw, tw[half], half, v);
#pragma unroll
              for (int k = 0; k < 4; ++k) { outw[k][2 * half] = cvt_pk_bf16(v[k][0], v[k][1]); outw[k][2 * half + 1] = cvt_pk_bf16(v[k][2], v[k][3]); }
          }
#pragma unroll
          for (int k = 0; k < 4; ++k) *(u32x4*)(BCc + (size_t)(t0 + l0 + k) * 1024 + cb0 + grp * 8) = outw[k];
        }
        LDS_BARRIER();
    }
}

struct SsdRegs { u32x4 b[4], c[4], x[5]; };
__device__ __forceinline__ void ssd_load_bc(SsdRegs& R, const bf16_t* BCc, int b, int g, int chunk, int tid) {
    const int t0 = b * SEQ + chunk * 128, row = tid >> 4, c16 = tid & 15;
#pragma unroll
    for (int k = 0; k < 4; ++k) { const int l = row + 32 * k;
        R.b[k] = *(const u32x4*)(BCc + (size_t)(t0 + l) * 1024 + g * 128 + c16 * 8);
        R.c[k] = *(const u32x4*)(BCc + (size_t)(t0 + l) * 1024 + 512 + g * 128 + c16 * 8); }
}
__device__ __forceinline__ void ssd_load_btx(SsdRegs& R, const bf16_t* BT, const bf16_t* ZX, int b, int g, int h, int chunk, int tid) {
    const int t0 = b * SEQ + chunk * 128; (void)BT; (void)g;
    const int grp = tid & 7, l0 = (tid >> 3) * 2;
    const bf16_t* src = ZX + (size_t)(t0 + l0 - 3) * ZXW + D_INNER + h * 64 + grp * 8;
#pragma unroll
    for (int r = 0; r < 5; ++r) { if (chunk == 0 && l0 + r < 3) R.x[r] = (u32x4){0u, 0u, 0u, 0u}; else R.x[r] = *(const u32x4*)(src + (size_t)r * ZXW); }
}
__device__ __forceinline__ void ssd_scan(LAS unsigned char* lds, int par, float d0, float d1, float Acoef, float Dsk, int lane) {
    LAS float* acs = (LAS float*)(lds + L_ACS + par * 512); LAS float* dts = (LAS float*)(lds + L_DTS + par * 512); LAS float* wdec = (LAS float*)(lds + L_WDEC + par * 512);
    LAS float* dskv = (LAS float*)(lds + L_DSK + par * 512);
    const float a0 = d0 * Acoef, a1 = d1 * Acoef; float s = a0 + a1;
#pragma unroll
    for (int o = 1; o < 64; o <<= 1) { const float n = __shfl_up(s, o); if (lane >= o) s += n; }
    const float last = __shfl(s, 63);
    acs[2 * lane] = s - a1; acs[2 * lane + 1] = s; dts[2 * lane] = d0; dts[2 * lane + 1] = d1;
    wdec[2 * lane] = __expf(last - (s - a1)); wdec[2 * lane + 1] = __expf(last - s);
    dskv[2 * lane] = Dsk / fmaxf(d0, 1e-30f); dskv[2 * lane + 1] = Dsk / fmaxf(d1, 1e-30f);
}

__device__ __forceinline__ void ssd_phase(CArgs& a, LAS unsigned char* lds, int tid, int wave, int lane) {
    unsigned char* ws = a.ws;
    bf16_t* ZX = (bf16_t*)(ws + WS_ZX); const float* DT = (const float*)(ws + WS_DT); float* SSQ = (float*)(ws + WS_SSQ);
    const bf16_t* BCc = (const bf16_t*)(ws + WS_BCC); const bf16_t* BT = (const bf16_t*)(ws + WS_BT);
    const float* conv_w = a.in[3]; const float* conv_b = a.in[4]; const float* a_log = a.in[6]; const float* d_skip = a.in[7];
    const int pt = wave & 3, lh = wave >> 2;
#define SSD_LAUNDER() int vt = tid; asm volatile("" : "+v"(vt)); const int fr = vt & 15, fq = (vt >> 4) & 3; (void)fr; (void)fq
    LAS bf16_t* Bs = (LAS bf16_t*)(lds + L_BS); LAS bf16_t* Btw = (LAS bf16_t*)(lds + L_BTW); LAS bf16_t* Cs = (LAS bf16_t*)(lds + L_CS);
    LAS bf16_t* Ms = (LAS bf16_t*)(lds + L_MS); LAS bf16_t* XDt = (LAS bf16_t*)(lds + L_XDT);
    LAS float* ssqp = (LAS float*)(lds + L_SSQ);
    constexpr float LOG2E = 1.44269504088896f;
    const int vcu_s = (gridDim.x % 8 == 0) ? (int)(blockIdx.x % 8) * (int)(gridDim.x / 8) + (int)(blockIdx.x / 8) : (int)blockIdx.x;
    for (int unit = vcu_s; unit < BATCH * SSM_HEADS; unit += gridDim.x) {
        const int b = unit >> 5, h = unit & 31, g = h >> 3;
        const float Acoef = -__expf(a_log[h]), Dsk = d_skip[h];
        f32x4 St[4];
#pragma unroll
        for (int i = 0; i < 4; ++i) St[i] = (f32x4){0.f, 0.f, 0.f, 0.f};
        { LAS u32x4* ex = (LAS u32x4*)(lds + L_EX) + (wave * 2) * 64 + lane; ex[0] = (u32x4){0u, 0u, 0u, 0u}; ex[64] = (u32x4){0u, 0u, 0u, 0u}; }
        if (tid < 8) { const int chan = h * 64 + tid * 8; LAS f32x4* tp = (LAS f32x4*)(lds + L_BTW) + tid * 10;
#pragma unroll
          for (int half = 0; half < 2; ++half) {
#pragma unroll
              for (int j = 0; j < 4; ++j) tp[half * 5 + j] = *(const f32x4*)(conv_w + j * CONV_DIM + chan + 4 * half);
              tp[half * 5 + 4] = *(const f32x4*)(conv_b + chan + 4 * half); } }
        SsdRegs R;
        ssd_load_bc(R, BCc, b, g, 0, tid); ssd_load_btx(R, BT, ZX, b, g, h, 0, tid);
        float dn0 = 0.f, dn1 = 0.f;
        if (wave == 7) { const int t0 = b * SEQ; ssd_scan(lds, 0, DT[(size_t)(t0 + 2 * lane) * 32 + h], DT[(size_t)(t0 + 2 * lane + 1) * 32 + h], Acoef, Dsk, lane); }
        for (int c = 0; c < SEQ / 128; ++c) {
            const int t0 = b * SEQ + c * 128;
            LAS float* acs = (LAS float*)(lds + L_ACS + (c & 1) * 512); LAS float* dts = (LAS float*)(lds + L_DTS + (c & 1) * 512); LAS float* wdec = (LAS float*)(lds + L_WDEC + (c & 1) * 512);
            LAS float* dskv = (LAS float*)(lds + L_DSK + (c & 1) * 512);
            LDS_BARRIER();
            { SSD_LAUNDER();
            if (wave == 7 && c + 1 < SEQ / 128) { dn0 = DT[(size_t)(t0 + 128 + 2 * (vt & 63)) * 32 + h]; dn1 = DT[(size_t)(t0 + 128 + 2 * (vt & 63) + 1) * 32 + h]; }
            { const int row = vt >> 4, c16 = vt & 15;
#pragma unroll
              for (int k = 0; k < 4; ++k) { const int l = row + 32 * k;
                  *(LAS u32x4*)(Bs + l * SST + c16 * 8) = R.b[k]; *(LAS u32x4*)(Cs + l * SST + c16 * 8) = R.c[k]; } }
            {
                const int grp = vt & 7, l0 = (vt >> 3) * 2;
                const float d0 = dts[l0], d1 = dts[l0 + 1];
                const LAS f32x4* tp = (const LAS f32x4*)(lds + L_BTW) + grp * 10;
#pragma unroll
                for (int half = 0; half < 2; ++half) {
                    f32x4 cwx[2][4], cbx[2];
#pragma unroll
                    for (int j = 0; j < 4; ++j) cwx[half][j] = tp[half * 5 + j];
                    cbx[half] = tp[half * 5 + 4];
#pragma unroll
                    for (int i = 0; i < 4; ++i) {
                        float s0 = cbx[half][i], s1 = s0;
#pragma unroll
                        for (int j = 0; j < 4; ++j) { const unsigned w0 = R.x[j][2 * half + (i >> 1)], w1 = R.x[j + 1][2 * half + (i >> 1)];
                            s0 += cwx[half][j][i] * ((i & 1) ? bfhi(w0) : bflo(w0)); s1 += cwx[half][j][i] * ((i & 1) ? bfhi(w1) : bflo(w1)); }
                        *(LAS unsigned*)(XDt + (grp * 8 + 4 * half + i) * SST + l0) = cvt_pk_bf16(silu_f(s0) * d0, silu_f(s1) * d1);
                    }
                }
            }
            if (c > 0 && vt < 128) { const f32x4 p = *(LAS f32x4*)(ssqp + vt * 4); SSQ[(size_t)(t0 - 128 + vt) * 32 + h] = (p[0] + p[1]) + (p[2] + p[3]); }
            }
            LDS_BARRIER();
            u32x2 zr[4];
            { SSD_LAUNDER(); if (c + 1 < SEQ / 128) ssd_load_bc(R, BCc, b, g, c + 1, vt);
#pragma unroll
              for (int aa = 0; aa < 4; ++aa) zr[aa] = *(const u32x2*)(ZX + (size_t)(t0 + 16 * (lh + 2 * aa) + fr) * ZXW + h * 64 + 16 * pt + 4 * fq);
            }
            f32x4 yacc[4];
#pragma unroll
            for (int aa = 0; aa < 4; ++aa) yacc[aa] = (f32x4){0.f, 0.f, 0.f, 0.f};
            { SSD_LAUNDER();
#pragma unroll
            for (int ks = 0; ks < 4; ++ks) {
                bf16x8 sop;
                if ((ks >> 1) == lh) { const f32x4 s0 = St[2 * (ks & 1)], s1 = St[2 * (ks & 1) + 1]; u32x4 w; w.x = cvt_pk_bf16(s0[0], s0[1]); w.y = cvt_pk_bf16(s0[2], s0[3]); w.z = cvt_pk_bf16(s1[0], s1[1]); w.w = cvt_pk_bf16(s1[2], s1[3]); sop = __builtin_bit_cast(bf16x8, w); }
                else sop = *(const LAS bf16x8*)(lds + L_EX + (((c & 1) * 8 + (wave ^ 4)) * 2 + (ks & 1)) * 1024 + (vt & 63) * 16);
#pragma unroll
                for (int aa = 0; aa < 4; ++aa) { const int lt = lh + 2 * aa; const LAS bf16_t* cp = Cs + (16 * lt + fr) * SST + 32 * ks + 4 * fq;
                    const u32x2 lo = *(const LAS u32x2*)cp, hi = *(const LAS u32x2*)(cp + 16); u32x4 w; w.x = lo.x; w.y = lo.y; w.z = hi.x; w.w = hi.y;
                    yacc[aa] = __builtin_amdgcn_mfma_f32_16x16x32_bf16(sop, __builtin_bit_cast(bf16x8, w), yacc[aa], 0, 0, 0); }
                asm volatile("" ::: "memory");
            }
#pragma unroll
            for (int aa = 0; aa < 4; ++aa) yacc[aa] *= __expf(acs[16 * (lh + 2 * aa) + fr]);
            }
            { SSD_LAUNDER();
                const float dec = __expf(acs[127]);
#pragma unroll
                for (int i = 0; i < 4; ++i) St[i] *= dec;
#pragma unroll 1
                for (int ks = 0; ks < 4; ++ks) {
                    const u32x4 xr = *(const LAS u32x4*)(XDt + (16 * pt + fr) * SST + 32 * ks + 8 * fq);
                    const f32x4 w0 = *(const LAS f32x4*)(wdec + 32 * ks + 8 * fq), w1 = *(const LAS f32x4*)(wdec + 32 * ks + 8 * fq + 4);
                    u32x4 xs; xs.x = cvt_pk_bf16(bflo(xr.x) * w0[0], bfhi(xr.x) * w0[1]); xs.y = cvt_pk_bf16(bflo(xr.y) * w0[2], bfhi(xr.y) * w0[3]);
                    xs.z = cvt_pk_bf16(bflo(xr.z) * w1[0], bfhi(xr.z) * w1[1]); xs.w = cvt_pk_bf16(bflo(xr.w) * w1[2], bfhi(xr.w) * w1[3]);
                    const bf16x8 bop = __builtin_bit_cast(bf16x8, xs);
#pragma unroll
                    for (int j = 0; j < 4; ++j) {
                        LAS bf16x4* tp = (LAS bf16x4*)(Bs + (32 * ks + 8 * fq + (fr >> 2)) * SST + 16 * (4 * lh + j) + 4 * (fr & 3));
                        const bf16x4 t0v = __builtin_amdgcn_ds_read_tr16_b64_v4i16(tp), t1v = __builtin_amdgcn_ds_read_tr16_b64_v4i16((LAS bf16x4*)((LAS bf16_t*)tp + 4 * SST));
                        const bf16x8 aop = {t0v[0], t0v[1], t0v[2], t0v[3], t1v[0], t1v[1], t1v[2], t1v[3]};
                        St[j] = __builtin_amdgcn_mfma_f32_16x16x32_bf16(aop, bop, St[j], 0, 0, 0); }
                    asm volatile("" ::: "memory");
                }
#pragma unroll
                for (int k2 = 0; k2 < 2; ++k2) { const f32x4 s0 = St[2 * k2], s1 = St[2 * k2 + 1]; u32x4 w; w.x = cvt_pk_bf16(s0[0], s0[1]); w.y = cvt_pk_bf16(s0[2], s0[3]); w.z = cvt_pk_bf16(s1[0], s1[1]); w.w = cvt_pk_bf16(s1[2], s1[3]);
                    *(LAS u32x4*)(lds + L_EX + ((((c + 1) & 1) * 8 + wave) * 2 + k2) * 1024 + (vt & 63) * 16) = w; }
            }
            { SSD_LAUNDER();
                int lt = 0, i = wave;
                while (i > lt) { i -= lt + 1; ++lt; }
                while (lt < 8) {
                    f32x4 gacc = {0.f, 0.f, 0.f, 0.f};
#pragma unroll
                    for (int ks = 0; ks < 4; ++ks) { const bf16x8 aop = *(const LAS bf16x8*)(Bs + (16 * i + fr) * SST + 32 * ks + 8 * fq), bop = *(const LAS bf16x8*)(Cs + (16 * lt + fr) * SST + 32 * ks + 8 * fq);
                        gacc = __builtin_amdgcn_mfma_f32_16x16x32_bf16(aop, bop, gacc, 0, 0, 0); }
                    const int l = 16 * lt + fr; const float al = acs[l] * LOG2E;
                    const f32x4 as4 = *(const LAS f32x4*)(acs + 16 * i + 4 * fq);
                    float mv[4];
#pragma unroll
                    for (int j = 0; j < 4; ++j) mv[j] = gacc[j] * __builtin_amdgcn_exp2f(al - as4[j] * LOG2E);
                    if (i == lt) { const float dk = dskv[l];
#pragma unroll
                        for (int j = 0; j < 4; ++j) { const int sr = 4 * fq + j; mv[j] = sr <= fr ? mv[j] : 0.f; if (sr == fr) mv[j] += dk; }
                        if ((lt & 1) == 0) *(LAS u32x2*)(Ms + l * SST + 16 * (i + 1) + 4 * fq) = (u32x2){0u, 0u}; }
                    u32x2 w; w.x = cvt_pk_bf16(mv[0], mv[1]); w.y = cvt_pk_bf16(mv[2], mv[3]);
                    *(LAS u32x2*)(Ms + l * SST + 16 * i + 4 * fq) = w;
                    i += 8; while (lt < 8 && i > lt) { i -= lt + 1; ++lt; }
                }
            }
            { SSD_LAUNDER();
            if (c + 1 < SEQ / 128) ssd_load_btx(R, BT, ZX, b, g, h, c + 1, vt);
            if (wave == 7 && c + 1 < SEQ / 128) ssd_scan(lds, (c + 1) & 1, dn0, dn1, Acoef, Dsk, vt & 63);
            }
            LDS_BARRIER();
            { SSD_LAUNDER();
#pragma unroll
            for (int aa = 0; aa < 4; ++aa) { const int lt = lh + 2 * aa;
                for (int ks = 0; ks <= (lt >> 1); ++ks) { const bf16x8 mop = *(const LAS bf16x8*)(Ms + (16 * lt + fr) * SST + 32 * ks + 8 * fq), xop = *(const LAS bf16x8*)(XDt + (16 * pt + fr) * SST + 32 * ks + 8 * fq);
                    yacc[aa] = __builtin_amdgcn_mfma_f32_16x16x32_bf16(xop, mop, yacc[aa], 0, 0, 0); } }
#pragma unroll
            for (int aa = 0; aa < 4; ++aa) { const int l = 16 * (lh + 2 * aa) + fr;
                const float y0 = yacc[aa][0] * silu_f(bflo(zr[aa].x)), y1 = yacc[aa][1] * silu_f(bfhi(zr[aa].x)), y2 = yacc[aa][2] * silu_f(bflo(zr[aa].y)), y3 = yacc[aa][3] * silu_f(bfhi(zr[aa].y));
                u32x2 w; w.x = cvt_pk_bf16(y0, y1); w.y = cvt_pk_bf16(y2, y3);
                *(u32x2*)(ZX + (size_t)(t0 + l) * ZXW + h * 64 + 16 * pt + 4 * fq) = w;
                float q = (y0 * y0 + y1 * y1) + (y2 * y2 + y3 * y3); q += __shfl_xor(q, 16); q += __shfl_xor(q, 32);
                if (fq == 0) ssqp[l * 4 + pt] = q; }
            }
        }
        LDS_BARRIER();
        if (tid < 128) { const f32x4 p = *(LAS f32x4*)(ssqp + tid * 4); SSQ[(size_t)(b * SEQ + SEQ - 128 + tid) * 32 + h] = (p[0] + p[1]) + (p[2] + p[3]); }
        LDS_BARRIER();
    }
#undef SSD_LAUNDER
}

__device__ __forceinline__ void gatenorm_phase(CArgs& a, int gtid, int ngt) {
    bf16_t* ZX = (bf16_t*)(a.ws + WS_ZX); const float* SSQ = (const float*)(a.ws + WS_SSQ);
    for (int it = gtid; it < T * 256; it += 4 * ngt) {
        u32x4 v[4]; f32x4 s0[4], s1[4]; u32x4* p[4];
#pragma unroll
        for (int k = 0; k < 4; ++k) { int i2 = it + k * ngt; if (i2 >= T * 256) i2 = it; const int t = i2 >> 8, c8 = i2 & 255, g = c8 >> 6;
            p[k] = (u32x4*)(ZX + (size_t)t * ZXW + c8 * 8); v[k] = *p[k];
            s0[k] = *(const f32x4*)(SSQ + (size_t)t * 32 + 8 * g); s1[k] = *(const f32x4*)(SSQ + (size_t)t * 32 + 8 * g + 4); }
#pragma unroll
        for (int k = 0; k < 4; ++k) { if (k > 0 && it + k * ngt >= T * 256) continue;
            const float rstd = rsqrtf(((s0[k][0] + s0[k][1]) + (s0[k][2] + s0[k][3]) + (s1[k][0] + s1[k][1]) + (s1[k][2] + s1[k][3])) * (1.f / 512.f) + EPS);
            u32x4 w = v[k];
            w.x = cvt_pk_bf16(bflo(w.x) * rstd, bfhi(w.x) * rstd); w.y = cvt_pk_bf16(bflo(w.y) * rstd, bfhi(w.y) * rstd);
            w.z = cvt_pk_bf16(bflo(w.z) * rstd, bfhi(w.z) * rstd); w.w = cvt_pk_bf16(bflo(w.w) * rstd, bfhi(w.w) * rstd);
            *p[k] = w; }
    }
}

constexpr int AST = 72;
constexpr int L_KS = 0, L_VT = 9216, L_ABUF = 18432, L_FLG = 36864;
constexpr float ATT_DEAD = -150.1f;
template <bool MASK>
__device__ __forceinline__ void attn_tile(const LAS bf16_t* Ks, const LAS bf16_t* Vt, const bf16x8 (&qf)[2], f32x4 (&oacc)[4], float& carry, int c, int quad, int kbase, int qpos) {
    float z[16];
#pragma unroll
    for (int k16 = 0; k16 < 4; ++k16) {
        f32x4 sacc = {0.f, 0.f, 0.f, 0.f};
        const int krow = 16 * (c >> 2) + 4 * k16 + (c & 3);
#pragma unroll
        for (int ks = 0; ks < 2; ++ks) { const bf16x8 aop = *(const LAS bf16x8*)(Ks + krow * AST + 32 * ks + 8 * quad);
            sacc = __builtin_amdgcn_mfma_f32_16x16x32_bf16(aop, qf[ks], sacc, 0, 0, 0); }
#pragma unroll
        for (int j = 0; j < 4; ++j) z[4 * k16 + j] = sacc[j];
    }
    float ls[16], later[16], suf = 0.f;
#pragma unroll
    for (int i = 15; i >= 0; --i) {
        const float z2 = z[i];
        const float sp = fmaxf(z2, 0.f) + __builtin_amdgcn_logf(1.f + __builtin_amdgcn_exp2f(-fabsf(z2)));
        ls[i] = z2 - sp; later[i] = suf;
        if (MASK) { if ((kbase + i) < qpos) suf -= sp; } else suf -= sp;
    }
    const float T0 = __shfl(suf, c), T1 = __shfl(suf, c + 16), T2 = __shfl(suf, c + 32), T3 = __shfl(suf, c + 48);
    const float qoff = carry + (quad < 1 ? T1 : 0.f) + (quad < 2 ? T2 : 0.f) + (quad < 3 ? T3 : 0.f);
    carry += (T0 + T1) + (T2 + T3);
    float p[16];
#pragma unroll
    for (int i = 0; i < 16; ++i) { float v = __builtin_amdgcn_exp2f(ls[i] + later[i] + qoff); if (MASK) { if (!((kbase + i) < qpos)) v = 0.f; } p[i] = v; }
#pragma unroll
    for (int s = 0; s < 2; ++s) {
        u32x4 w; w.x = cvt_pk_bf16(p[8 * s + 0], p[8 * s + 1]); w.y = cvt_pk_bf16(p[8 * s + 2], p[8 * s + 3]); w.z = cvt_pk_bf16(p[8 * s + 4], p[8 * s + 5]); w.w = cvt_pk_bf16(p[8 * s + 6], p[8 * s + 7]);
        const bf16x8 pa = __builtin_bit_cast(bf16x8, w);
#pragma unroll
        for (int dt = 0; dt < 4; ++dt) { const bf16x8 bop = *(const LAS bf16x8*)(Vt + (16 * dt + c) * AST + 16 * quad + 8 * s);
            oacc[dt] = __builtin_amdgcn_mfma_f32_16x16x32_bf16(pa, bop, oacc[dt], 0, 0, 0); }
    }
}
__device__ __forceinline__ void attn_phase(CArgs& a, LAS unsigned char* lds, int tid, int wave, int lane) {
    const bf16_t* KVQ = (const bf16_t*)(a.ws + WS_KVQ); bf16_t* AO = (bf16_t*)(a.ws + WS_AO);
    LAS unsigned* flg = (LAS unsigned*)(lds + L_FLG);
    const int c = lane & 15, quad = lane >> 4;
    const int lkey = (tid & 31) + 32 * (tid >> 8), ldg = (tid >> 5) & 7;
    constexpr int NQB = SEQ / 128, NUNITS = BATCH * 16 * NQB;
    constexpr float QSC = 0.125f * 1.44269504088896f;
    u32x4 nq0, nq1, nkA, nvA, nkB, nvB;
#define ATT_PRELOAD(UNIT) { const int qb_ = (UNIT) % NQB, bh_ = (UNIT) / NQB, h_ = bh_ & 15, b_ = bh_ >> 4; const size_t tr_ = (size_t)b_ * SEQ; const int kt_ = 2 * qb_ + 1; \
        const bf16_t* qp_ = KVQ + (tr_ + 128 * qb_ + 16 * wave + c) * KVQW + 2048 + h_ * 64 + 8 * quad; nq0 = *(const u32x4*)qp_; nq1 = *(const u32x4*)(qp_ + 32); \
        const bf16_t* s_ = KVQ + (tr_ + lkey) * KVQW + h_ * 64 + 8 * ldg; \
        nkA = *(const u32x4*)(s_ + (size_t)(64 * kt_) * KVQW); nvA = *(const u32x4*)(s_ + (size_t)(64 * kt_) * KVQW + 1024); \
        nkB = *(const u32x4*)(s_ + (size_t)(64 * (kt_ - 1)) * KVQW); nvB = *(const u32x4*)(s_ + (size_t)(64 * (kt_ - 1)) * KVQW + 1024); }
    const int vcu_a = (gridDim.x % 8 == 0) ? (int)(blockIdx.x % 8) * (int)(gridDim.x / 8) + (int)(blockIdx.x / 8) : (int)blockIdx.x;
    if (vcu_a < NUNITS) ATT_PRELOAD(vcu_a)
    for (int unit = vcu_a; unit < NUNITS; unit += gridDim.x) {
        const int qb = unit % NQB, bh = unit / NQB, h = bh & 15, b = bh >> 4;
        const int qw0 = 128 * qb + 16 * wave;
        const size_t trow = (size_t)b * SEQ;
        bf16x8 qf[2];
        { u32x4 w = nq0;
            w.x = cvt_pk_bf16(bflo(w.x) * QSC, bfhi(w.x) * QSC); w.y = cvt_pk_bf16(bflo(w.y) * QSC, bfhi(w.y) * QSC);
            w.z = cvt_pk_bf16(bflo(w.z) * QSC, bfhi(w.z) * QSC); w.w = cvt_pk_bf16(bflo(w.w) * QSC, bfhi(w.w) * QSC); qf[0] = __builtin_bit_cast(bf16x8, w);
            w = nq1;
            w.x = cvt_pk_bf16(bflo(w.x) * QSC, bfhi(w.x) * QSC); w.y = cvt_pk_bf16(bflo(w.y) * QSC, bfhi(w.y) * QSC);
            w.z = cvt_pk_bf16(bflo(w.z) * QSC, bfhi(w.z) * QSC); w.w = cvt_pk_bf16(bflo(w.w) * QSC, bfhi(w.w) * QSC); qf[1] = __builtin_bit_cast(bf16x8, w); }
        f32x4 oacc[4];
#pragma unroll
        for (int i = 0; i < 4; ++i) oacc[i] = (f32x4){0.f, 0.f, 0.f, 0.f};
        float carry = 0.f; bool wave_alive = true;
        if (tid < 16) flg[tid] = 1u;
        int kt = 2 * qb + 1;
        const bf16_t* src0 = KVQ + (trow + lkey) * KVQW + h * 64 + 8 * ldg;
        u32x4 kA = nkA, vA = nvA, kB = nkB, vB = nvB;
        if (unit + (int)gridDim.x < NUNITS) ATT_PRELOAD(unit + (int)gridDim.x)
#define ATT_STEP(KR, VR, ITV) { \
            LAS bf16_t* Ks = (LAS bf16_t*)(lds + ((ITV) & 1) * L_ABUF + L_KS); LAS bf16_t* Vt = (LAS bf16_t*)(lds + ((ITV) & 1) * L_ABUF + L_VT); \
            *(LAS u32x4*)(Ks + lkey * AST + 8 * ldg) = KR; \
            Vt[(8 * ldg + 0) * AST + lkey] = (bf16_t)(VR.x & 0xffffu); Vt[(8 * ldg + 1) * AST + lkey] = (bf16_t)(VR.x >> 16); \
            Vt[(8 * ldg + 2) * AST + lkey] = (bf16_t)(VR.y & 0xffffu); Vt[(8 * ldg + 3) * AST + lkey] = (bf16_t)(VR.y >> 16); \
            Vt[(8 * ldg + 4) * AST + lkey] = (bf16_t)(VR.z & 0xffffu); Vt[(8 * ldg + 5) * AST + lkey] = (bf16_t)(VR.z >> 16); \
            Vt[(8 * ldg + 6) * AST + lkey] = (bf16_t)(VR.w & 0xffffu); Vt[(8 * ldg + 7) * AST + lkey] = (bf16_t)(VR.w >> 16); \
            LDS_BARRIER(); \
            if ((ITV) > 0) { unsigned alive = 0u; \
                _Pragma("unroll") for (int i = 0; i < 8; ++i) alive |= flg[(((ITV) - 1) & 1) * 8 + i]; \
                if (!alive) goto att_done; } \
            if (kt > 1) { KR = *(const u32x4*)(src0 + (size_t)(64 * (kt - 2)) * KVQW); VR = *(const u32x4*)(src0 + (size_t)(64 * (kt - 2)) * KVQW + 1024); }     \
            const int tk0 = 64 * kt; \
            if (wave_alive && tk0 < qw0 + 15) { \
                if (tk0 + 63 >= qw0) attn_tile<true>(Ks, Vt, qf, oacc, carry, c, quad, tk0 + 16 * quad, qw0 + c); \
                else attn_tile<false>(Ks, Vt, qf, oacc, carry, c, quad, tk0 + 16 * quad, qw0 + c); \
                wave_alive = __ballot(carry > ATT_DEAD) != 0ull; \
            } \
            if (lane == 0) flg[((ITV) & 1) * 8 + wave] = wave_alive ? 1u : 0u; \
            if (kt == 0) goto att_done; \
            --kt; }
        for (int it = 0;; it += 2) {
            ATT_STEP(kA, vA, it)
            ATT_STEP(kB, vB, it + 1)
        }
        att_done:;
#undef ATT_STEP
#pragma unroll
        for (int dt = 0; dt < 4; ++dt)
#pragma unroll
            for (int j = 0; j < 4; ++j) AO[(trow + qw0 + 4 * quad + j) * D_MODEL + h * 64 + 16 * dt + c] = (bf16_t)(cvt_pk_bf16(oacc[dt][j], 0.f) & 0xffffu);
        LDS_BARRIER();
    }
#undef ATT_PRELOAD
}

__device__ __forceinline__ void final_norm(const bf16_t* Hb, float* X, const float* w, int gw, int NGW, int lane, int npert) {
    f32x4 wv[4];
#pragma unroll
    for (int j = 0; j < 2; ++j) { wv[2 * j] = *(const f32x4*)(w + 512 * j + lane * 8); wv[2 * j + 1] = *(const f32x4*)(w + 512 * j + lane * 8 + 4); }
    for (int m = gw; m < T; m += NGW) {
        f32x4 v[4]; float s = 0.f;
#pragma unroll
        for (int j = 0; j < 2; ++j) { const u32x4 hb = *(const u32x4*)(Hb + (size_t)m * D_MODEL + 512 * j + lane * 8);
            v[2 * j] = (f32x4){bflo(hb.x), bfhi(hb.x), bflo(hb.y), bfhi(hb.y)}; v[2 * j + 1] = (f32x4){bflo(hb.z), bfhi(hb.z), bflo(hb.w), bfhi(hb.w)}; }
#pragma unroll
        for (int j = 0; j < 4; ++j) s += (v[j].x * v[j].x + v[j].y * v[j].y) + (v[j].z * v[j].z + v[j].w * v[j].w);
        const float rstd = rsqrtf(wave_sum(s) * (1.f / D_MODEL) + EPS);
#pragma unroll
        for (int j = 0; j < 4; ++j) { f32x4 o = v[j] * rstd * wv[j];
            const int fi = m * D_MODEL + 512 * (j >> 1) + lane * 8 + 4 * (j & 1);
            if (npert > 0) {
#pragma unroll
                for (int e = 0; e < 4; ++e) if (fi + e < npert) o[e] += 0.1f; }
            *(f32x4*)(X + fi) = o; }
    }
}

__device__ __forceinline__ void dt_gemm(const bf16_t* XNp, const bf16_t* WdtT  , const float* bias, float* DT, int gw, int NGW, int lane) {
    const int fr = lane & 15, fq = lane >> 4;
    for (int strip = gw; strip < T / 16; strip += NGW) {
        const bf16_t* ap = XNp + (size_t)(strip * 16 + fr) * 1024 + 8 * fq; const bf16_t* bp = WdtT + (size_t)fr * 1024 + 8 * fq;
        f32x4 a0 = {0.f, 0.f, 0.f, 0.f}, a1 = a0;
#pragma unroll 8
        for (int ks = 0; ks < 32; ++ks) { const bf16x8 av = *(const bf16x8*)(ap + 32 * ks), b0 = *(const bf16x8*)(bp + 32 * ks), b1 = *(const bf16x8*)(bp + 16 * 1024 + 32 * ks);
            a0 = __builtin_amdgcn_mfma_f32_16x16x32_bf16(av, b0, a0, 0, 0, 0); a1 = __builtin_amdgcn_mfma_f32_16x16x32_bf16(av, b1, a1, 0, 0, 0); }
        const float bb0 = bias[fr], bb1 = bias[16 + fr];
#pragma unroll
        for (int j = 0; j < 4; ++j) { float* o = DT + (size_t)(strip * 16 + 4 * fq + j) * 32; o[fr] = softplus_f(a0[j] + bb0); o[16 + fr] = softplus_f(a1[j] + bb1); }
    }
}

#define XB_TMO      128
#define XB_XCNT(j)  (256  + 64 * (j))
#define XB_XSUB(j)  (1280 + 64 * (j))
#define XB_XGEN(j)  (2304 + 64 * (j))
#define XB_TOP      3328
#define XB_TOPGEN   3392
#define XCD_BAR_WORDS 3456
#define XB_SPIN_CAP (1u << 22)
constexpr size_t WS_BAR = 65536;
constexpr int L_XB = 163840 - 16;
__device__ __forceinline__ unsigned xb_ld(unsigned* p)              { return __hip_atomic_load(p, __ATOMIC_RELAXED, __HIP_MEMORY_SCOPE_AGENT); }
__device__ __forceinline__ unsigned xb_add(unsigned* p, unsigned v) { return __hip_atomic_fetch_add(p, v, __ATOMIC_RELAXED, __HIP_MEMORY_SCOPE_AGENT); }
__device__ __forceinline__ unsigned xb_xcc_id() { return (unsigned)__builtin_amdgcn_s_getreg((3 << 11) | 20) & 0xFu; }
#define XB_SPIN(cond, bar) do { unsigned _sp = 0; while (cond) { __builtin_amdgcn_s_sleep(1); \
    if ((++_sp & 255u) == 0u) { if (xb_ld(&(bar)[XB_TMO])) break; if (_sp > XB_SPIN_CAP) { atomicAdd(&(bar)[XB_TMO], 1u); break; } } } } while (0)
__device__ __forceinline__ void xcd_barrier_complete(unsigned* bar, unsigned x, unsigned& nloc, unsigned& nx) {
    const unsigned G = gridDim.x * gridDim.y * gridDim.z;
    unsigned sum, cnt, mine, sp = 0u;
    for (;;) {
        sum = 0u; cnt = 0u; mine = 0u;
#pragma unroll
        for (unsigned j = 0; j < 16; ++j) { const unsigned c = xb_ld(&bar[XB_XCNT(j)]); sum += c; cnt += (c > 0u) ? 1u : 0u; mine = (j == x) ? c : mine; }
        if (sum == G) break;
        __builtin_amdgcn_s_sleep(1);
        if ((++sp & 255u) == 0u) { if (xb_ld(&bar[XB_TMO])) break; if (sp > XB_SPIN_CAP) { atomicAdd(&bar[XB_TMO], 1u); break; } }
    }
    nloc = mine > 0u ? mine : 1u; nx = cnt > 0u ? cnt : 1u;
}
__device__ __forceinline__ void xcd_barrier(unsigned* bar, volatile LAS unsigned* st) {
    asm volatile("s_waitcnt vmcnt(0)" ::: "memory");
    __syncthreads();
    if (threadIdx.x == 0) {
        const unsigned x = xb_xcc_id();
        __builtin_amdgcn_s_waitcnt(0);
        unsigned nloc = st[0], nx = st[1];
        if (nloc == 0u) { xcd_barrier_complete(bar, x, nloc, nx); st[0] = nloc; st[1] = nx; }
        const unsigned old = xb_add(&bar[XB_XSUB(x)], 1u);
        const unsigned gen = old / nloc;
        if (old + 1u == (gen + 1u) * nloc) {
            __builtin_amdgcn_fence(__ATOMIC_RELEASE, "agent");
            asm volatile("s_waitcnt vmcnt(0)" ::: "memory");
            const unsigned og = xb_add(&bar[XB_TOP], 1u);
            const unsigned tg = og / nx;
            if (og + 1u == (tg + 1u) * nx) xb_add(&bar[XB_TOPGEN], 1u);
            else XB_SPIN(xb_ld(&bar[XB_TOPGEN]) == tg, bar);
            __builtin_amdgcn_fence(__ATOMIC_ACQUIRE, "agent");
            xb_add(&bar[XB_XGEN(x)], 1u);
            asm volatile("s_waitcnt vmcnt(0)" ::: "memory");
        } else {
            XB_SPIN(xb_ld(&bar[XB_XGEN(x)]) == gen, bar);
            __builtin_amdgcn_fence(__ATOMIC_ACQUIRE, "agent");
            asm volatile("s_waitcnt vmcnt(0)" ::: "memory");
        }
    }
    __syncthreads();
}

constexpr int NPHASES = 13;
__device__ __forceinline__ CArgs& fresh_args() {
    CArgs* p = (CArgs*)__builtin_amdgcn_kernarg_segment_ptr();
    asm volatile("" : "+s"(p));
    return *p;
}
__global__ void __launch_bounds__(NTHREADS, 2) yoco_fwd(Args args_unused) {
#define args fresh_args()
    extern __shared__ __attribute__((aligned(16))) unsigned char lds_raw[];
    LAS unsigned char* lds = (LAS unsigned char*)lds_raw;
    const int tid = threadIdx.x, lane = tid & 63, wave = __builtin_amdgcn_readfirstlane(tid >> 6);
    const int G = gridDim.x, gw = blockIdx.x * 8 + wave, NGW = G * 8;
#define ws (args.ws)
#define XN ((bf16_t*)(ws + WS_XN))
#define H (args.out)
    const int lo = args.ph_lo, hi = args.ph_hi;
#define IN(k) (lo <= (k) && (k) < hi)
#define STAMP(k) do { if (MK_PROBE_A >= 0 && blockIdx.x == 0 && threadIdx.x == 0) ((unsigned long long*)ws)[k] = __builtin_amdgcn_s_memrealtime(); } while (0)
#define SEAM(k) do { if (IN(k) && IN((k) + 1)) xcd_barrier((unsigned*)(ws + WS_BAR), (volatile LAS unsigned*)(lds + L_XB)); STAMP((k) + 1); } while (0)
    if (hi - lo > 1) {
        if (tid < 2) ((volatile LAS unsigned*)(lds + L_XB))[tid] = 0u;
        __syncthreads();
        if (tid == 0) (void)xb_add(&((unsigned*)(ws + WS_BAR))[XB_XCNT(xb_xcc_id())], 1u);
    }
    if (lo < 0) cg::this_grid().sync();
    STAMP(0);
    if (IN(0)) { p0_prologue(args, lds, gw, NGW, wave, lane); } SEAM(0);
    if (IN(1)) {
        pg8::Gemm g{XN, (const bf16_t*)(ws + WS_WIN), nullptr}; pg8::StaticOrder<T / 256, ZXW / 256> S; S.init(G, blockIdx.x);
        pg8::EpiInProj E{(bf16_t*)(ws + WS_ZX)};
        pg8::gemm_phase<pg8::EpiInProj, false, true, 1024, 1024>(lds, g, S, E);
        dt_gemm(XN, (const bf16_t*)(ws + WS_WIN) + (size_t)ZXW * 1024, args.in[5], (float*)(ws + WS_DT), gw, NGW, lane);
    } SEAM(1);
    if (IN(2)) { bcconv_phase(args, lds, tid); } SEAM(2);
    if (IN(3)) { ssd_phase(args, lds, tid, wave, lane); } SEAM(3);
    if (IN(4)) {
        pg8::Gemm g{(const bf16_t*)(ws + WS_ZX), (const bf16_t*)(ws + WS_WOUT), (const float*)(ws + WS_SSQ)}; pg8::StaticOrder<T / 256, 4> S; S.init(G, blockIdx.x);
        pg8::EpiRes<true, true> E{args.in[0], XN, (float*)(ws + WS_SSQP), lds};
        pg8::gemm_phase<pg8::EpiRes<true, true>, false, true, 2048, ZXW, true>(lds, g, S, E);
    } SEAM(4);
#define FFN_BLOCK(layer, pb) \
    if (IN(pb)) { \
        pg8::Gemm g{XN, (const bf16_t*)(ws + WS_WUP) + (size_t)layer * FF2 * 1024, nullptr}; pg8::StaticOrder<133, 22> S; S.init(G, blockIdx.x); \
        pg8::EpiFfn E{(bf16_t*)(ws + WS_ACT), args.in[18] + (size_t)layer * 3 * FF2, args.in[19] + (size_t)layer * FF2, (const float*)(ws + WS_SSQP), lds}; \
        pg8::gemm_phase<pg8::EpiFfn, true, true, 1024, 1024>(lds, g, S, E); \
    } SEAM(pb); \
    if (IN(pb + 1)) { \
        pg8::Gemm g{(const bf16_t*)(ws + WS_ACT), (const bf16_t*)(ws + WS_WDN) + (size_t)layer * 1024 * D_FF, nullptr}; pg8::StaticOrder<T / 256, 4> S; S.init(G, blockIdx.x); \
        pg8::EpiRes<false> E{nullptr, XN, (float*)(ws + WS_SSQP), lds}; \
        pg8::gemm_phase<pg8::EpiRes<false>, false, true, D_FF, D_FF>(lds, g, S, E); \
    } SEAM(pb + 1);
    FFN_BLOCK(0, 5)
    if (IN(7)) {
        pg8::Gemm g{XN, (const bf16_t*)(ws + WS_WKVQ), nullptr}; pg8::StaticOrder<T / 256, KVQW / 256> S; S.init(G, blockIdx.x);
        pg8::EpiBf16 E{(bf16_t*)(ws + WS_KVQ), KVQW, (const float*)(ws + WS_SSQP), lds};
        pg8::gemm_phase<pg8::EpiBf16, false, true, 1024, 1024>(lds, g, S, E);
    } SEAM(7);
    if (IN(8)) { attn_phase(args, lds, tid, wave, lane); } SEAM(8);
    if (IN(9)) {
        pg8::Gemm g{(const bf16_t*)(ws + WS_AO), (const bf16_t*)(ws + WS_WO), nullptr}; pg8::StaticOrder<T / 256, 4> S; S.init(G, blockIdx.x);
        pg8::EpiRes<false> E{nullptr, XN, (float*)(ws + WS_SSQP), lds};
        pg8::gemm_phase<pg8::EpiRes<false>, false, true, 1024, 1024>(lds, g, S, E);
    } SEAM(9);
    FFN_BLOCK(1, 10)
#undef FFN_BLOCK
    if (IN(12)) { int npert = 0; if (MK_PROBE_A >= 0) { const unsigned long long* st = (const unsigned long long*)ws; npert = (int)((st[MK_PROBE_B < 0 ? 0 : MK_PROBE_B] - st[MK_PROBE_A < 0 ? 0 : MK_PROBE_A]) / 10ull); }
        final_norm(XN, H, args.in[21], gw, NGW, lane, npert); }
#undef IN
#undef SEAM
#undef ws
#undef XN
#undef H
#undef args
}

#ifndef MK_MULTI
#define MK_MULTI 0
#endif
extern "C" void kernel_launch(void* const* d_in, const int* in_sizes, int n_in, void* d_out, int out_size, void* d_ws, size_t ws_size, hipStream_t stream) {
    static int grid = 0;
    if (grid == 0) {
        if (n_in != 22 || out_size != T * D_MODEL || ws_size < WS_END) { fprintf(stderr, "kernel_launch: unexpected sizes n_in %d out %d ws %zu\n", n_in, out_size, ws_size); grid = -1; return; }
        int dev = 0, cus = 0, per_cu = 0;
        hipGetDevice(&dev); hipDeviceGetAttribute(&cus, hipDeviceAttributeMultiprocessorCount, dev);
        if (hipFuncSetAttribute((const void*)yoco_fwd, hipFuncAttributeMaxDynamicSharedMemorySize, LDS_BYTES) != hipSuccess) { fprintf(stderr, "kernel_launch: hipFuncSetAttribute failed\n"); grid = -1; return; }
        if (hipOccupancyMaxActiveBlocksPerMultiprocessor(&per_cu, (const void*)yoco_fwd, NTHREADS, LDS_BYTES) != hipSuccess || per_cu < 1) per_cu = 1;
        (void)hipGetLastError();
        grid = cus * per_cu;
        fprintf(stderr, "kernel_launch: grid %d (cus %d x %d)\n", grid, cus, per_cu);
    }
    if (grid < 0) return;
    (void)hipMemsetAsync((char*)d_ws + WS_BAR, 0, 16384, stream);
    Args a{};
    for (int i = 0; i < 22; ++i) a.in[i] = (const float*)d_in[i];
    a.out = (float*)d_out; a.ws = (unsigned char*)d_ws;
#if MK_MULTI
    for (int p = 0; p < NPHASES; ++p) { a.ph_lo = p; a.ph_hi = p + 1; hipLaunchKernelGGL(yoco_fwd, dim3(grid), dim3(NTHREADS), LDS_BYTES, stream, a); }
#else
    a.ph_lo = 0; a.ph_hi = NPHASES;
    void* kargs[] = {&a};
    hipError_t e = hipLaunchCooperativeKernel((const void*)yoco_fwd, dim3(grid), dim3(NTHREADS), kargs, LDS_BYTES, stream);
    if (e != hipSuccess) fprintf(stderr, "cooperative launch failed: %s (grid %d)\n", hipGetErrorString(e), grid);
#endif
}
```

```cpp
#include <hip/hip_runtime.h>
#include <hip/hip_cooperative_groups.h>
#include <cstdio>
#include <cstdint>
namespace cg = cooperative_groups;
#ifndef MK_PROBE_A
#define MK_PROBE_A -1
#define MK_PROBE_B -1
#endif

#define LAS __attribute__((address_space(3)))
typedef unsigned short bf16_t;
typedef short bf16x8 __attribute__((ext_vector_type(8)));
typedef short bf16x4 __attribute__((ext_vector_type(4)));
typedef float f32x4 __attribute__((ext_vector_type(4)));
typedef unsigned u32x4 __attribute__((ext_vector_type(4)));
typedef unsigned u32x2 __attribute__((ext_vector_type(2)));

constexpr int D_MODEL = 1024, BATCH = 8, SEQ = 4096, T = BATCH * SEQ;
constexpr int D_INNER = 2048, SSM_HEADS = 32, GN = 512, CONV_DIM = 3072, IN_PROJ = 5152;
constexpr int ZXW = 5120;
constexpr int NIN_PAD = 5376;
constexpr int D_FF = 2816, FF2 = 5632;
constexpr int KVQW = 3072;
constexpr float EPS = 1e-6f;

constexpr size_t MiB = 1u << 20;
constexpr size_t WS_WIN = 1 * MiB, WS_WOUT = 12 * MiB, WS_WKVQ = 16 * MiB, WS_WO = 22 * MiB, WS_WUP = 24 * MiB, WS_WDN = 46 * MiB;
constexpr size_t WS_DT = 57 * MiB, WS_SSQ = 61 * MiB, WS_XN = 66 * MiB, WS_BIG = 132 * MiB;
constexpr size_t WS_ZX = WS_BIG;
constexpr size_t WS_ACT = WS_BIG;
constexpr size_t WS_AO = WS_BIG;
constexpr size_t WS_KVQ = 308 * MiB;
constexpr size_t WS_END = 500 * MiB;

constexpr int NTHREADS = 512;
constexpr int LDS_BYTES = 163840;

__device__ __forceinline__ unsigned cvt_pk_bf16(float lo, float hi) { unsigned r; asm volatile("v_cvt_pk_bf16_f32 %0, %1, %2" : "=v"(r) : "v"(lo), "v"(hi)); return r; }
__device__ __forceinline__ float bf2f(unsigned short u) { return __uint_as_float((unsigned)u << 16); }
__device__ __forceinline__ float bflo(unsigned u) { return __uint_as_float(u << 16); }
__device__ __forceinline__ float bfhi(unsigned u) { return __uint_as_float(u & 0xffff0000u); }
__device__ __forceinline__ float wave_sum(float v) {
#pragma unroll
    for (int o = 1; o < 64; o <<= 1) v += __shfl_xor(v, o);
    return v;
}
__device__ __forceinline__ float silu_f(float x) { return x * __builtin_amdgcn_rcpf(1.f + __builtin_amdgcn_exp2f(x * -1.44269504088896f)); }
__device__ __forceinline__ float softplus_f(float x) { return fmaxf(x, 0.f) + log1pf(__expf(-fabsf(x))); }
__device__ __forceinline__ float rot_row(float v, int which) {
    int iv = __builtin_bit_cast(int, v), r;
    if (which == 1) r = __builtin_amdgcn_update_dpp(0, iv, 0x121, 0xf, 0xf, false);
    else r = __builtin_amdgcn_update_dpp(0, iv, 0x122, 0xf, 0xf, false);
    return __builtin_bit_cast(float, r);
}

#define LDS_BARRIER() do { asm volatile("s_waitcnt lgkmcnt(0)" ::: "memory"); __builtin_amdgcn_s_barrier(); asm volatile("" ::: "memory"); } while (0)
__device__ __forceinline__ float row_sum16(float v) {
    v += __builtin_bit_cast(float, __builtin_amdgcn_update_dpp(0, __builtin_bit_cast(int, v), 0x128, 0xf, 0xf, false));
    v += __builtin_bit_cast(float, __builtin_amdgcn_update_dpp(0, __builtin_bit_cast(int, v), 0x124, 0xf, 0xf, false));
    v += __builtin_bit_cast(float, __builtin_amdgcn_update_dpp(0, __builtin_bit_cast(int, v), 0x122, 0xf, 0xf, false));
    v += __builtin_bit_cast(float, __builtin_amdgcn_update_dpp(0, __builtin_bit_cast(int, v), 0x121, 0xf, 0xf, false));
    return v;
}
__device__ __forceinline__ float shr_row(float cur, float prev, int n) {
    const int ic = __builtin_bit_cast(int, cur), ip = __builtin_bit_cast(int, prev); int r;
    if (n == 1) { const int t = __builtin_amdgcn_update_dpp(0, ip, 0x121, 0xf, 0xf, false); r = __builtin_amdgcn_update_dpp(t, ic, 0x111, 0xf, 0xf, false); }
    else { const int t = __builtin_amdgcn_update_dpp(0, ip, 0x122, 0xf, 0xf, false); r = __builtin_amdgcn_update_dpp(t, ic, 0x112, 0xf, 0xf, false); }
    return __builtin_bit_cast(float, r);
}
namespace pg8 {
constexpr int BM = 256, BK = 64, HALF = 128, HTB = HALF * BK * 2, STAGE_BYTES = 8 * HTB, NXCD = 8, WGM = 8;
__host__ __device__ __forceinline__ int lds_byte(int r, int c) { const int st = (r >> 4) * 2 + (c >> 5), rr = r & 15, cc = c & 31, ob = rr * 64 + cc * 2; return st * 1024 + (ob ^ (((ob >> 9) & 1) << 5)); }
__host__ __device__ __forceinline__ void stage_rc(int b, int& R, int& C) { const int st = b / 1024, sb = b % 1024, swz = sb ^ (((sb >> 9) & 1) << 5); R = (st >> 1) * 16 + swz / 64; C = (st & 1) * 32 + (swz % 64) / 2; }
__host__ __device__ __forceinline__ int perm32(int rho) { const int n = rho >> 4, i = rho & 15; return 8 * (i >> 2) + 4 * n + (i & 3); }

struct Unit { int pm, pn, par; };
struct Gemm { const bf16_t* A; const bf16_t* Bt; const float* ssq; };
constexpr int LDS_TAB = 131072;

template <int nM, int nN>
struct StaticOrder {
    static constexpr int nwg = nM * nN;
    int G, c;
    __device__ void init(int G_, int c_) { G = G_; c = c_; }
    __device__ bool next(int i, Unit& u) const {
        const int L = i * G + c; if (L >= nwg) return false;
        int wgid = L; { constexpr int q = nwg / NXCD, r = nwg % NXCD; const int xcd = wgid % NXCD, off = wgid / NXCD; wgid = (xcd < r ? xcd * (q + 1) : r * (q + 1) + (xcd - r) * q) + off; }
        constexpr int nig = WGM * nN; const int gid = wgid / nig, fm = gid * WGM, gsz = (nM - fm) < WGM ? (nM - fm) : WGM;
        u.pm = fm + ((wgid % nig) % gsz); u.pn = (wgid % nig) / gsz; return true;
    }
};

template <class Epi, bool AMAP62, bool ALIGN_EPI, int K, int lda, bool SEGS = false, class Sched>
__device__ __forceinline__ void gemm_phase(LAS unsigned char* lds, const Gemm g, const Sched& S, const Epi& E) {
    const int tid = threadIdx.x, wid = __builtin_amdgcn_readfirstlane(tid >> 6), lane = tid & 63, wr = wid >> 2, wc = wid & 3, fr = lane & 15, fq = lane >> 4;
    constexpr int nt = K / BK;
    unsigned voffA[2], voffB[2];
#pragma unroll
    for (int i = 0; i < 2; ++i) { int R, C; stage_rc(tid * 16 + i * 8192, R, C); const int Rb = Epi::PERM ? ((R & ~31) + perm32(R & 31)) : R;
        const int Ra = AMAP62 ? (62 * (R >> 6) + (R & 63)) : R;
        voffA[i] = (unsigned)(Ra * lda + C) * 2u; voffB[i] = (unsigned)(Rb * K + C) * 2u; }
    constexpr size_t kstep = (size_t)(BK * 2);
    constexpr size_t hstepA = (size_t)(AMAP62 ? 124 : 128) * lda * 2, tstepA = (size_t)(AMAP62 ? 248 : 256) * lda * 2;
    constexpr size_t hstepB = (size_t)HALF * K * 2, tstepB = 2 * hstepB;
    const char* baseA = (const char*)g.A - (AMAP62 ? (size_t)2 * lda * 2 : (size_t)0);
    const unsigned ldsw = (unsigned)wid * 1024u;
    const int aoff = lds_byte(wr * 64 + fr, fq * 8), boff = lds_byte(wc * 32 + fr, fq * 8);
#define PG8_SA(b, h) (((b) * 2 + (h)) * HTB)
#define PG8_SB(b, h) ((4 + (b) * 2 + (h)) * HTB)
#define PG8_STAGE(bufoff, gbase, voff) do { _Pragma("unroll") for (int _i = 0; _i < 2; ++_i) \
        __builtin_amdgcn_global_load_lds((const unsigned*)((const char*)(gbase) + (voff)[_i]), (LAS unsigned*)(lds + (bufoff) + ldsw + _i * 8192), 16, 0, 0); } while (0)
#define PG8_LDA(dst, b, h) do { _Pragma("unroll") for (int m = 0; m < 4; ++m) _Pragma("unroll") for (int k = 0; k < 2; ++k) dst[m][k] = *(const LAS bf16x8*)(lds + PG8_SA(b, h) + aoff + m * 2048 + k * 1024); } while (0)
#define PG8_LDB(dst, b, h) do { _Pragma("unroll") for (int n = 0; n < 2; ++n) _Pragma("unroll") for (int k = 0; k < 2; ++k) dst[n][k] = *(const LAS bf16x8*)(lds + PG8_SB(b, h) + boff + n * 2048 + k * 1024); } while (0)
#define PG8_MMA(ai, bj, At, Bt) do { __builtin_amdgcn_s_setprio(1); _Pragma("unroll") for (int m = 0; m < 4; ++m) _Pragma("unroll") for (int n = 0; n < 2; ++n) _Pragma("unroll") for (int k = 0; k < 2; ++k) \
        acc[ai][bj][m][n] = __builtin_amdgcn_mfma_f32_16x16x32_bf16(Bt[n][k], At[m][k], acc[ai][bj][m][n], 0, 0, 0); __builtin_amdgcn_s_setprio(0); } while (0)
#define PG8_WAIT_V(n) asm volatile("s_waitcnt vmcnt(" #n ")" ::: "memory")
#define PG8_WAIT_L(n) asm volatile("s_waitcnt lgkmcnt(" #n ")" ::: "memory")
#define PG8_BAR __builtin_amdgcn_s_barrier()
#define PG8_SCHED __builtin_amdgcn_sched_barrier(0)
    Unit cur, nxt; int ui = 0;
    if (!S.next(0, cur)) return;
    cur.par = 0;
    if constexpr (Epi::STAGE) E.stage(lds, cur, tid);
    f32x4 acc[2][2][4][2];
#pragma unroll
    for (int a = 0; a < 2; ++a)
#pragma unroll
        for (int b = 0; b < 2; ++b)
#pragma unroll
            for (int m = 0; m < 4; ++m)
#pragma unroll
                for (int n = 0; n < 2; ++n) acc[a][b][m][n] = (f32x4){0.f, 0.f, 0.f, 0.f};
    bf16x8 At[4][2], B0[2][2], B1[2][2];
    const char* cA = baseA + (size_t)cur.pm * tstepA; const char* cB = (const char*)g.Bt + (size_t)cur.pn * tstepB;
    PG8_STAGE(PG8_SB(0, 0), cB, voffB); PG8_STAGE(PG8_SB(0, 1), cB + hstepB, voffB); PG8_STAGE(PG8_SA(0, 0), cA, voffA); PG8_STAGE(PG8_SA(0, 1), cA + hstepA, voffA);
    if (wr == 1) PG8_BAR;
    PG8_WAIT_V(2); PG8_BAR;
    PG8_STAGE(PG8_SB(1, 0), cB + kstep, voffB); PG8_STAGE(PG8_SA(1, 0), cA + kstep, voffA); PG8_STAGE(PG8_SB(1, 1), cB + hstepB + kstep, voffB);
    PG8_WAIT_V(6); PG8_BAR;
    for (;;) {
        const bool has_next = S.next(ui + 1, nxt); nxt.par = (ui + 1) & 1;
        const char* nA = has_next ? baseA + (size_t)nxt.pm * tstepA : cA; const char* nB = has_next ? (const char*)g.Bt + (size_t)nxt.pn * tstepB : cB;
        for (int t = 0; t < nt; t += 2) {
            const bool last = (t == nt - 2);
            if constexpr (SEGS) {
                if (t == 2 && tid < 256) {
                    const float* sp = g.ssq + (size_t)(cur.pm * 256 + tid) * 32; float r[4];
#pragma unroll
                    for (int q = 0; q < 4; ++q) { const f32x4 a = *(const f32x4*)(sp + 8 * q), b = *(const f32x4*)(sp + 8 * q + 4);
                        r[q] = rsqrtf((((a[0] + a[1]) + (a[2] + a[3])) + ((b[0] + b[1]) + (b[2] + b[3]))) * (1.f / 512.f) + EPS); }
                    *(LAS f32x4*)(lds + LDS_TAB + tid * 16) = (f32x4){r[0] / r[1], r[1] / r[2], r[2] / r[3], r[3]};
                }
                if (t == 8 || t == 16 || t == 24) { const int sidx = (t >> 3) - 1;
#pragma unroll
                    for (int a = 0; a < 2; ++a)
#pragma unroll
                        for (int m = 0; m < 4; ++m) { const float f = *(const LAS float*)(lds + LDS_TAB + (a * HALF + wr * 64 + m * 16 + fr) * 16 + sidx * 4);
#pragma unroll
                            for (int b = 0; b < 2; ++b)
#pragma unroll
                                for (int n = 0; n < 2; ++n) acc[a][b][m][n] *= f; } }
            }
            const char* a1 = cA + (size_t)(t + 1) * kstep;
            const char* a2 = last ? nA : cA + (size_t)(t + 2) * kstep; const char* b2 = last ? nB : cB + (size_t)(t + 2) * kstep;
            const char* a3 = a2 + kstep; const char* b3 = b2 + kstep;
            PG8_LDB(B0, 0, 0); PG8_LDB(B1, 0, 1); PG8_SCHED; PG8_LDA(At, 0, 0); PG8_STAGE(PG8_SA(1, 1), a1 + hstepA, voffA);
            PG8_WAIT_V(8); PG8_WAIT_L(0); PG8_BAR; PG8_MMA(0, 0, At, B0); PG8_MMA(0, 1, At, B1); PG8_BAR; PG8_SCHED;
            PG8_LDA(At, 0, 1); PG8_STAGE(PG8_SB(0, 0), b2, voffB); PG8_STAGE(PG8_SB(0, 1), b2 + hstepB, voffB); PG8_STAGE(PG8_SA(0, 0), a2, voffA);
            PG8_WAIT_V(8); PG8_WAIT_L(0); PG8_BAR; PG8_MMA(1, 0, At, B0); PG8_MMA(1, 1, At, B1); PG8_BAR; PG8_SCHED;
            PG8_LDB(B0, 1, 0); PG8_LDB(B1, 1, 1); PG8_SCHED; PG8_LDA(At, 1, 0); PG8_STAGE(PG8_SA(0, 1), a2 + hstepA, voffA);
            PG8_WAIT_V(8); PG8_WAIT_L(0); PG8_BAR; PG8_MMA(0, 0, At, B0); PG8_MMA(0, 1, At, B1); PG8_BAR; PG8_SCHED;
            PG8_LDA(At, 1, 1); PG8_STAGE(PG8_SB(1, 0), b3, voffB); PG8_STAGE(PG8_SB(1, 1), b3 + hstepB, voffB); PG8_STAGE(PG8_SA(1, 0), a3, voffA);
            PG8_WAIT_V(8); PG8_WAIT_L(0); PG8_BAR; PG8_MMA(1, 0, At, B0); PG8_MMA(1, 1, At, B1); PG8_BAR; PG8_SCHED;
        }
        if constexpr (ALIGN_EPI) { if (wr == 0) PG8_BAR; }
        E(acc, cur, wr, wc, fr, fq);
        if (!has_next) break;
#pragma unroll
        for (int a = 0; a < 2; ++a)
#pragma unroll
            for (int b = 0; b < 2; ++b)
#pragma unroll
                for (int m = 0; m < 4; ++m)
#pragma unroll
                    for (int n = 0; n < 2; ++n) acc[a][b][m][n] = (f32x4){0.f, 0.f, 0.f, 0.f};
        cur = nxt; cA = nA; cB = nB; ++ui;
        if constexpr (Epi::STAGE) E.stage(lds, cur, tid);
        if constexpr (ALIGN_EPI) { if (wr == 1) PG8_BAR; }
    }
    PG8_WAIT_V(0);
    if constexpr (!ALIGN_EPI) { if (wr == 0) PG8_BAR; }
    PG8_BAR;
#undef PG8_SA
#undef PG8_SB
#undef PG8_STAGE
#undef PG8_LDA
#undef PG8_LDB
#undef PG8_MMA
#undef PG8_WAIT_V
#undef PG8_WAIT_L
#undef PG8_BAR
#undef PG8_SCHED
}

__device__ __forceinline__ void rows_rstd(const float* ssqp, const int (&rows)[8], int fq, float (&rs)[8]) {
    f32x4 pv[8];
#pragma unroll
    for (int i = 0; i < 8; ++i) pv[i] = *(const f32x4*)(ssqp + (size_t)rows[i] * 16 + 4 * fq);
#pragma unroll
    for (int i = 0; i < 8; ++i) { float a = (pv[i][0] + pv[i][1]) + (pv[i][2] + pv[i][3]); a += __shfl_xor(a, 16); a += __shfl_xor(a, 32); rs[i] = rsqrtf(a * (1.f / D_MODEL) + EPS); }
}
struct EpiBf16 {
    static constexpr bool PERM = true, STAGE = true;
    bf16_t* O; int ldc; const float* ssqp; const LAS unsigned char* ldsb;
    __device__ __forceinline__ void stage(LAS unsigned char* lds, const Unit& u, int tid) const {
        if (tid < 256) { const f32x4* p = (const f32x4*)(ssqp + (size_t)(u.pm * BM + tid) * 16); const f32x4 a = (p[0] + p[1]) + (p[2] + p[3]);
            *(LAS float*)(lds + LDS_TAB + u.par * 1024 + tid * 4) = rsqrtf(((a[0] + a[1]) + (a[2] + a[3])) * (1.f / D_MODEL) + EPS); }
    }
    __device__ __forceinline__ void operator()(f32x4 (&acc)[2][2][4][2], const Unit& u, int wr, int wc, int fr, int fq) const {
        const int row0 = u.pm * BM + wr * 64 + fr, col0 = u.pn * BM + wc * 32 + 8 * fq;
#pragma unroll
        for (int ai = 0; ai < 2; ++ai)
#pragma unroll
            for (int m = 0; m < 4; ++m) { const int row = row0 + ai * HALF + m * 16; bf16_t* rowp = O + (size_t)row * ldc + col0;
                const float r = *(const LAS float*)(ldsb + LDS_TAB + u.par * 1024 + (ai * HALF + wr * 64 + m * 16 + fr) * 4);
#pragma unroll
                for (int bj = 0; bj < 2; ++bj) { const f32x4 v0 = acc[ai][bj][m][0] * r, v1 = acc[ai][bj][m][1] * r;
                    u32x4 w; w.x = cvt_pk_bf16(v0[0], v0[1]); w.y = cvt_pk_bf16(v0[2], v0[3]); w.z = cvt_pk_bf16(v1[0], v1[1]); w.w = cvt_pk_bf16(v1[2], v1[3]);
                    *(u32x4*)(rowp + bj * HALF) = w; } }
    }
};
struct EpiInProj {
    static constexpr bool PERM = true, STAGE = false;
    bf16_t* ZX;
    __device__ __forceinline__ void operator()(f32x4 (&acc)[2][2][4][2], const Unit& u, int wr, int wc, int fr, int fq) const {
        const int row0 = u.pm * BM + wr * 64 + fr, col0 = u.pn * BM + wc * 32 + 8 * fq;
#pragma unroll
        for (int ai = 0; ai < 2; ++ai)
#pragma unroll
            for (int m = 0; m < 4; ++m) { bf16_t* rowp = ZX + (size_t)(row0 + ai * HALF + m * 16) * ZXW + col0;
#pragma unroll
                for (int bj = 0; bj < 2; ++bj) { const f32x4 v0 = acc[ai][bj][m][0], v1 = acc[ai][bj][m][1];
                    u32x4 w; w.x = cvt_pk_bf16(v0[0], v0[1]); w.y = cvt_pk_bf16(v0[2], v0[3]); w.z = cvt_pk_bf16(v1[0], v1[1]); w.w = cvt_pk_bf16(v1[2], v1[3]);
                    *(u32x4*)(rowp + bj * HALF) = w; } }
    }
};
template <bool BASE_F32, bool SEGS = false>
struct EpiRes {
    static constexpr bool PERM = true, STAGE = false;
    const float* basef; bf16_t* xn; float* ssqp; const LAS unsigned char* ldsb;
    __device__ __forceinline__ void operator()(f32x4 (&acc)[2][2][4][2], const Unit& u, int wr, int wc, int fr, int fq) const {
        const int col0 = u.pn * BM + wc * 32 + 8 * fq;
        if (!BASE_F32) {
            u32x4 hb[2][4][2];
#pragma unroll
            for (int ai = 0; ai < 2; ++ai)
#pragma unroll
                for (int m = 0; m < 4; ++m)
#pragma unroll
                    for (int bj = 0; bj < 2; ++bj) hb[ai][m][bj] = *(const u32x4*)(xn + (size_t)(u.pm * BM + ai * HALF + wr * 64 + m * 16 + fr) * D_MODEL + col0 + bj * HALF);
#pragma unroll
            for (int ai = 0; ai < 2; ++ai)
#pragma unroll
                for (int m = 0; m < 4; ++m) { const int row = u.pm * BM + ai * HALF + wr * 64 + m * 16 + fr; const size_t off = (size_t)row * D_MODEL + col0; float sq = 0.f;
#pragma unroll
                    for (int bj = 0; bj < 2; ++bj) { const u32x4 h = hb[ai][m][bj];
                        const f32x4 o0 = (f32x4){bflo(h.x), bfhi(h.x), bflo(h.y), bfhi(h.y)} + acc[ai][bj][m][0], o1 = (f32x4){bflo(h.z), bfhi(h.z), bflo(h.w), bfhi(h.w)} + acc[ai][bj][m][1];
                        sq += ((o0[0] * o0[0] + o0[1] * o0[1]) + (o0[2] * o0[2] + o0[3] * o0[3])) + ((o1[0] * o1[0] + o1[1] * o1[1]) + (o1[2] * o1[2] + o1[3] * o1[3]));
                        u32x4 w; w.x = cvt_pk_bf16(o0[0], o0[1]); w.y = cvt_pk_bf16(o0[2], o0[3]); w.z = cvt_pk_bf16(o1[0], o1[1]); w.w = cvt_pk_bf16(o1[2], o1[3]);
                        *(u32x4*)(xn + off + bj * HALF) = w; }
                    sq += __shfl_xor(sq, 16); sq += __shfl_xor(sq, 32);
                    if (fq == 0) ssqp[(size_t)row * 16 + u.pn * 4 + wc] = sq; }
        } else {
#pragma unroll
        for (int ai = 0; ai < 2; ++ai)
#pragma unroll
            for (int m = 0; m < 4; ++m) { const int row = u.pm * BM + ai * HALF + wr * 64 + m * 16 + fr; const size_t off = (size_t)row * D_MODEL + col0; float sq = 0.f;
                if (SEGS) { const float f = *(const LAS float*)(ldsb + LDS_TAB + (ai * HALF + wr * 64 + m * 16 + fr) * 16 + 12);
#pragma unroll
                    for (int bj = 0; bj < 2; ++bj) { acc[ai][bj][m][0] *= f; acc[ai][bj][m][1] *= f; } }
#pragma unroll
                for (int bj = 0; bj < 2; ++bj) { const size_t o = off + bj * HALF;
                    const f32x4 b0 = *(const f32x4*)(basef + o), b1 = *(const f32x4*)(basef + o + 4);
                    const f32x4 o0 = b0 + acc[ai][bj][m][0], o1 = b1 + acc[ai][bj][m][1];
                    sq += ((o0[0] * o0[0] + o0[1] * o0[1]) + (o0[2] * o0[2] + o0[3] * o0[3])) + ((o1[0] * o1[0] + o1[1] * o1[1]) + (o1[2] * o1[2] + o1[3] * o1[3]));
                    u32x4 w; w.x = cvt_pk_bf16(o0[0], o0[1]); w.y = cvt_pk_bf16(o0[2], o0[3]); w.z = cvt_pk_bf16(o1[0], o1[1]); w.w = cvt_pk_bf16(o1[2], o1[3]);
                    *(u32x4*)(xn + o) = w; }
                sq += __shfl_xor(sq, 16); sq += __shfl_xor(sq, 32);
                if (fq == 0) ssqp[(size_t)row * 16 + u.pn * 4 + wc] = sq;
                asm volatile("" ::: "memory"); }
        }
    }
};
struct EpiFfn {
    static constexpr bool PERM = true, STAGE = true;
    bf16_t* ACT; const float* cw; const float* cb; const float* ssqp; const LAS unsigned char* ldsb;
    static constexpr int FTAB_R = LDS_TAB, FTAB_W = LDS_TAB + 1024, FTAB_STRIDE = 5120;
    __device__ __forceinline__ void stage(LAS unsigned char* lds, const Unit& u, int tid) const {
        if (tid < 256) { const int kind = tid >> 5, c4 = tid & 31, ch = u.pn * 128 + 4 * c4, k3 = kind & 3;
            const float* src = (k3 < 3 ? cw + k3 * FF2 : cb) + (kind >= 4 ? D_FF : 0) + ch;
            *(LAS f32x4*)(lds + u.par * FTAB_STRIDE + FTAB_W + kind * 512 + c4 * 16) = *(const f32x4*)src;
        } else { const int R = tid - 256; int t = u.pm * 248 + 62 * (R >> 6) - 2 + (R & 63); t = t < 0 ? 0 : (t >= T ? T - 1 : t);
            const f32x4* p = (const f32x4*)(ssqp + (size_t)t * 16); const f32x4 a = (p[0] + p[1]) + (p[2] + p[3]);
            *(LAS float*)(lds + u.par * FTAB_STRIDE + FTAB_R + R * 4) = rsqrtf(((a[0] + a[1]) + (a[2] + a[3])) * (1.f / D_MODEL) + EPS); }
    }
    __device__ __forceinline__ void operator()(f32x4 (&acc)[2][2][4][2], const Unit& u, int wr, int wc, int fr, int fq) const {
#pragma unroll
        for (int ai = 0; ai < 2; ++ai)
#pragma unroll
            for (int m = 0; m < 4; ++m) { const float r = *(const LAS float*)(ldsb + u.par * FTAB_STRIDE + FTAB_R + (ai * HALF + wr * 64 + m * 16 + fr) * 4);
#pragma unroll
                for (int bj = 0; bj < 2; ++bj)
#pragma unroll
                    for (int n = 0; n < 2; ++n) acc[ai][bj][m][n] *= r; }
#pragma unroll
        for (int n = 0; n < 2; ++n) {
            const int ch = u.pn * 128 + wc * 32 + 8 * fq + 4 * n;
            const LAS unsigned char* wp = ldsb + u.par * FTAB_STRIDE + FTAB_W + (wc * 32 + 8 * fq + 4 * n) * 4;
            const f32x4 gw0 = *(const LAS f32x4*)(wp), gw1 = *(const LAS f32x4*)(wp + 512), gw2 = *(const LAS f32x4*)(wp + 1024), gb = *(const LAS f32x4*)(wp + 1536);
            const f32x4 vw0 = *(const LAS f32x4*)(wp + 2048), vw1 = *(const LAS f32x4*)(wp + 2560), vw2 = *(const LAS f32x4*)(wp + 3072), vb = *(const LAS f32x4*)(wp + 3584);
#pragma unroll
            for (int ai = 0; ai < 2; ++ai) {
                const int trow0 = u.pm * 248 + 62 * (2 * ai + wr) - 2, p0 = trow0 & (SEQ - 1);
                const bool has_start = (p0 >= SEQ - 63) || (p0 <= 1);
#define FFN_ROWS(MASKED) \
                _Pragma("unroll") for (int m = 0; m < 4; ++m) { \
                    const f32x4 xg = acc[ai][0][m][n], xv = acc[ai][1][m][n]; \
                    const f32x4 og = acc[ai][0][m > 0 ? m - 1 : 0][n], ov = acc[ai][1][m > 0 ? m - 1 : 0][n];     \
                    f32x4 g1, g2, v1, v2; \
                    _Pragma("unroll") for (int j = 0; j < 4; ++j) { g1[j] = shr_row(xg[j], og[j], 1); g2[j] = shr_row(xg[j], og[j], 2); v1[j] = shr_row(xv[j], ov[j], 1); v2[j] = shr_row(xv[j], ov[j], 2); } \
                    const int i = 16 * m + fr, t = trow0 + i; \
                    if (MASKED) { const int pos = t & (SEQ - 1); \
                        if (pos == 0) { g1 = (f32x4){0.f, 0.f, 0.f, 0.f}; v1 = g1; } \
                        if (pos <= 1) { g2 = (f32x4){0.f, 0.f, 0.f, 0.f}; v2 = g2; } } \
                    const f32x4 cgv = gb + gw0 * g2 + gw1 * g1 + gw2 * xg, cvv = vb + vw0 * v2 + vw1 * v1 + vw2 * xv; \
                    float a[4]; \
                    _Pragma("unroll") for (int j = 0; j < 4; ++j) a[j] = silu_f(cgv[j]) * cvv[j]; \
                    if (i >= 2 && t < T) { u32x2 w; w.x = cvt_pk_bf16(a[0], a[1]); w.y = cvt_pk_bf16(a[2], a[3]); *(u32x2*)(ACT + (size_t)t * D_FF + ch) = w; } \
                    asm volatile("" ::: "memory"); \
                }
                if (has_start) { FFN_ROWS(true) } else { FFN_ROWS(false) }
#undef FFN_ROWS
            }
        }
    }
};
}

struct Args {
    const float* in[22];
    float* out; unsigned char* ws;
    int ph_lo, ph_hi;
};
typedef const __attribute__((address_space(4))) Args CArgs;

__device__ __forceinline__ void transpose_item(const float* W, int K, int N, bf16_t* WTrow0  , const float* kscale, LAS float* scr, int k0, int n0, int lane) {
    float tv[32];
#pragma unroll
    for (int i = 0; i < 32; ++i) { const int kk = 2 * i + (lane >> 5); tv[i] = W[(size_t)(k0 + kk) * N + n0 + (lane & 31)]; }
    if (kscale) {
#pragma unroll
        for (int i = 0; i < 32; ++i) tv[i] *= kscale[k0 + 2 * i + (lane >> 5)]; }
#pragma unroll
    for (int i = 0; i < 32; ++i) { const int kk = 2 * i + (lane >> 5); scr[kk * 33 + (lane & 31)] = tv[i]; }
    asm volatile("s_waitcnt lgkmcnt(0)" ::: "memory");
    const int c = lane & 7;
#pragma unroll
    for (int j = 0; j < 4; ++j) { const int n = (lane >> 3) + 8 * j; const LAS float* s = scr + (8 * c) * 33 + n;
        u32x4 o; o.x = cvt_pk_bf16(s[0 * 33], s[1 * 33]); o.y = cvt_pk_bf16(s[2 * 33], s[3 * 33]); o.z = cvt_pk_bf16(s[4 * 33], s[5 * 33]); o.w = cvt_pk_bf16(s[6 * 33], s[7 * 33]);
        *(u32x4*)(WTrow0 + (size_t)n * K + k0 + 8 * c) = o; }
    asm volatile("s_waitcnt lgkmcnt(0)" ::: "memory");
}
__device__ __forceinline__ void rms_rows_bf16(const float* X, bf16_t* O, int gw, int NGW, int lane) {
    for (int m = gw; m < T; m += 2 * NGW) {
        const int m1 = m + NGW < T ? m + NGW : m;
        const f32x4* xr0 = (const f32x4*)(X + (size_t)m * D_MODEL) + lane; const f32x4* xr1 = (const f32x4*)(X + (size_t)m1 * D_MODEL) + lane;
        f32x4 v0[4], v1[4]; float s0 = 0.f, s1 = 0.f;
#pragma unroll
        for (int j = 0; j < 4; ++j) { v0[j] = xr0[64 * j]; v1[j] = xr1[64 * j]; }
#pragma unroll
        for (int j = 0; j < 4; ++j) { s0 += (v0[j].x * v0[j].x + v0[j].y * v0[j].y) + (v0[j].z * v0[j].z + v0[j].w * v0[j].w); s1 += (v1[j].x * v1[j].x + v1[j].y * v1[j].y) + (v1[j].z * v1[j].z + v1[j].w * v1[j].w); }
        const float r0 = rsqrtf(wave_sum(s0) * (1.f / D_MODEL) + EPS), r1 = rsqrtf(wave_sum(s1) * (1.f / D_MODEL) + EPS);
        u32x2* o0 = (u32x2*)(O + (size_t)m * D_MODEL) + lane; u32x2* o1 = (u32x2*)(O + (size_t)m1 * D_MODEL) + lane;
#pragma unroll
        for (int j = 0; j < 4; ++j) { u32x2 w; w.x = cvt_pk_bf16(v0[j].x * r0, v0[j].y * r0); w.y = cvt_pk_bf16(v0[j].z * r0, v0[j].w * r0); o0[64 * j] = w; }
        if (m1 != m) {
#pragma unroll
            for (int j = 0; j < 4; ++j) { u32x2 w; w.x = cvt_pk_bf16(v1[j].x * r1, v1[j].y * r1); w.y = cvt_pk_bf16(v1[j].z * r1, v1[j].w * r1); o1[64 * j] = w; } }
    }
}

__device__ __forceinline__ void p0_prologue(CArgs& a, LAS unsigned char* lds, int gw, int NGW, int wave, int lane) {
    LAS float* scr = (LAS float*)(lds + wave * 16384);
    unsigned char* ws = a.ws;
    const float* ssm_norm_w = a.in[1]; const float* ssm_in_w = a.in[2]; const float* gate_norm_w = a.in[8]; const float* ssm_out_w = a.in[9];
    const float* kv_norm_w = a.in[10]; const float* w_k = a.in[11]; const float* w_v = a.in[12]; const float* attn_norm_w = a.in[13]; const float* w_q = a.in[14]; const float* w_o = a.in[15];
    const float* ffn_norm_w = a.in[16]; const float* ffn_up_w = a.in[17]; const float* ffn_down_w = a.in[20];
    bf16_t* WIN = (bf16_t*)(ws + WS_WIN); bf16_t* WOUT = (bf16_t*)(ws + WS_WOUT); bf16_t* WKVQ = (bf16_t*)(ws + WS_WKVQ); bf16_t* WO = (bf16_t*)(ws + WS_WO);
    bf16_t* WUP = (bf16_t*)(ws + WS_WUP); bf16_t* WDN = (bf16_t*)(ws + WS_WDN);
    constexpr int I_IN = 16 * 161, I_OUT = 32 * 32, I_SQ = 16 * 32, I_UP = 16 * 176, I_DN = 44 * 32;
    constexpr int NITEMS = I_IN + I_OUT + 4 * I_SQ + 2 * I_UP + 2 * I_DN;
    for (int it = gw; it < NITEMS; it += NGW) {
        int r = it;
        if (r < I_IN) { const int kb = r / 161, nb = r % 161; transpose_item(ssm_in_w, 1024, IN_PROJ, WIN + (size_t)(32 * nb) * 1024, ssm_norm_w, scr, 64 * kb, 32 * nb, lane); continue; } r -= I_IN;
        if (r < I_OUT) { const int kb = r / 32, nb = r % 32; transpose_item(ssm_out_w, 2048, 1024, WOUT + (size_t)(32 * nb) * 2048, gate_norm_w, scr, 64 * kb, 32 * nb, lane); continue; } r -= I_OUT;
        if (r < I_SQ) { const int kb = r / 32, nb = r % 32; transpose_item(w_k, 1024, 1024, WKVQ + (size_t)(32 * nb) * 1024, kv_norm_w, scr, 64 * kb, 32 * nb, lane); continue; } r -= I_SQ;
        if (r < I_SQ) { const int kb = r / 32, nb = r % 32; transpose_item(w_v, 1024, 1024, WKVQ + (size_t)(1024 + 32 * nb) * 1024, kv_norm_w, scr, 64 * kb, 32 * nb, lane); continue; } r -= I_SQ;
        if (r < I_SQ) { const int kb = r / 32, nb = r % 32; transpose_item(w_q, 1024, 1024, WKVQ + (size_t)(2048 + 32 * nb) * 1024, attn_norm_w, scr, 64 * kb, 32 * nb, lane); continue; } r -= I_SQ;
        if (r < I_SQ) { const int kb = r / 32, nb = r % 32; transpose_item(w_o, 1024, 1024, WO + (size_t)(32 * nb) * 1024, nullptr, scr, 64 * kb, 32 * nb, lane); continue; } r -= I_SQ;
        if (r < 2 * I_UP) { const int l = r / I_UP; r -= l * I_UP; const int kb = r / 176, nb = r % 176; const int n0 = 32 * nb;
            const int drow = n0 < D_FF ? 256 * (n0 / 128) + (n0 % 128) : 256 * ((n0 - D_FF) / 128) + 128 + ((n0 - D_FF) % 128);
            transpose_item(ffn_up_w + (size_t)l * 1024 * FF2, 1024, FF2, WUP + (size_t)l * FF2 * 1024 + (size_t)drow * 1024, ffn_norm_w + l * 1024, scr, 64 * kb, n0, lane); continue; } r -= 2 * I_UP;
        { const int l = r / I_DN; r -= l * I_DN; const int kb = r / 32, nb = r % 32;
            transpose_item(ffn_down_w + (size_t)l * D_FF * 1024, D_FF, 1024, WDN + (size_t)l * 1024 * D_FF + (size_t)(32 * nb) * D_FF, nullptr, scr, 64 * kb, 32 * nb, lane); }
    }
    { u32x4* z = (u32x4*)(WIN + (size_t)IN_PROJ * 1024); const int n16 = 224 * 1024 * 2 / 16;
      for (int i = gw * 64 + lane; i < n16; i += NGW * 64) z[i] = (u32x4){0u, 0u, 0u, 0u}; }
    rms_rows_bf16(a.in[0], (bf16_t*)(ws + WS_XN), gw, NGW, lane);
}

constexpr int SST = 136;
constexpr int L_BS = 0, L_BTW = 34816, L_CS = 69632, L_MS = 104448, L_XDT = 139264, L_ACS = 156672, L_DTS = 157696, L_WDEC = 158720, L_DSK = 159744, L_SSQ = 160768, L_EX = L_BTW + 2048;
static_assert(L_SSQ + 2048 <= LDS_BYTES, "ssd lds");
constexpr size_t WS_BCC = WS_XN;
constexpr size_t WS_SSQP = WS_DT;
constexpr size_t WS_BT = 452 * MiB;

template <int NR>
__device__ __forceinline__ void conv_half(const u32x4 (&raw)[7], const float* cw, const float* cb, int chan4, int half, float (&outv)[4][4]) {
    f32x4 w[4];
#pragma unroll
    for (int j = 0; j < 4; ++j) w[j] = *(const f32x4*)(cw + j * CONV_DIM + chan4);
    const f32x4 b = *(const f32x4*)(cb + chan4);
#pragma unroll
    for (int k = 0; k < NR; ++k)
#pragma unroll
        for (int i = 0; i < 4; ++i) {
            float s = b[i];
#pragma unroll
            for (int j = 0; j < 4; ++j) { const unsigned wd = raw[k + j][2 * half + (i >> 1)]; const float x = (i & 1) ? bfhi(wd) : bflo(wd); s += w[j][i] * x; }
            outv[k][i] = silu_f(s);
        }
}

template <int NR>
__device__ __forceinline__ void conv_half_pre(const u32x4 (&raw)[7], const f32x4 (&w)[5], int half, float (&outv)[4][4]) {
#pragma unroll
    for (int k = 0; k < NR; ++k)
#pragma unroll
        for (int i = 0; i < 4; ++i) {
            float s = w[4][i];
#pragma unroll
            for (int j = 0; j < 4; ++j) { const unsigned wd = raw[k + j][2 * half + (i >> 1)]; const float x = (i & 1) ? bfhi(wd) : bflo(wd); s += w[j][i] * x; }
            outv[k][i] = silu_f(s);
        }
}
__device__ __forceinline__ void bcconv_phase(CArgs& a, LAS unsigned char* lds, int tid) {
    const bf16_t* ZX = (const bf16_t*)(a.ws + WS_ZX); bf16_t* BCc = (bf16_t*)(a.ws + WS_BCC);
    const float* conv_w = a.in[3]; const float* conv_b = a.in[4];
    LAS bf16_t* raw = (LAS bf16_t*)lds;
    for (int unit = blockIdx.x; unit < BATCH * 32 * 8; unit += gridDim.x) {
        const int which = unit & 1, g = (unit >> 1) & 3, c = (unit >> 3) & 31, b = unit >> 8;
        const int t0 = b * SEQ + c * 128, cb0 = which * GN + g * 128;
        const bf16_t* src = ZX + (size_t)(t0 - 3) * ZXW + 2 * D_INNER + cb0;
        f32x4 tw[2][5];
        { const int chan = D_INNER + cb0 + (tid & 15) * 8;
#pragma unroll
          for (int half = 0; half < 2; ++half) {
#pragma unroll
              for (int j = 0; j < 4; ++j) tw[half][j] = *(const f32x4*)(conv_w + j * CONV_DIM + chan + 4 * half);
              tw[half][4] = *(const f32x4*)(conv_b + chan + 4 * half); } }
#pragma unroll
        for (int k = 0; k < 5; ++k) { const int idx = tid + 512 * k, row = idx >> 4, c16 = idx & 15;
            if (row < 131) { u32x4 v = (u32x4){0u, 0u, 0u, 0u}; if (!(c == 0 && row < 3)) v = *(const u32x4*)(src + (size_t)row * ZXW + c16 * 8);
                *(LAS u32x4*)(raw + row * SST + c16 * 8) = v; } }
        LDS_BARRIER();
        { const int grp = tid & 15, l0 = (tid >> 4) * 4, chan = D_INNER + cb0 + grp * 8;
          u32x4 rw[7];
#pragma unroll
          for (int r = 0; r < 7; ++r) rw[r] = *(const LAS u32x4*)(raw + (l0 + r) * SST + grp * 8);
          u32x4 outw[4];
#pragma unroll
          for (int half = 0; half < 2; ++half) {
              float v[4][4];
              conv_half_pre<4>(rw, tw[half], half, v);
#pragma unroll
              for (int k = 0; k < 4; ++k) { outw[k][2 * half] = cvt_pk_bf16(v[k][0], v[k][1]); outw[k][2 * half + 1] = cvt_pk_bf16(v[k][2], v[k][3]); }
          }
#pragma unroll
          for (int k = 0; k < 4; ++k) *(u32x4*)(BCc + (size_t)(t0 + l0 + k) * 1024 + cb0 + grp * 8) = outw[k];
        }
        LDS_BARRIER();
    }
}

struct SsdRegs { u32x4 b[4], c[4], x[5]; };
__device__ __forceinline__ void ssd_load_bc(SsdRegs& R, const bf16_t* BCc, int b, int g, int chunk, int tid) {
    const int t0 = b * SEQ + chunk * 128, row = tid >> 4, c16 = tid & 15;
#pragma unroll
    for (int k = 0; k < 4; ++k) { const int l = row + 32 * k;
        R.b[k] = *(const u32x4*)(BCc + (size_t)(t0 + l) * 1024 + g * 128 + c16 * 8);
        R.c[k] = *(const u32x4*)(BCc + (size_t)(t0 + l) * 1024 + 512 + g * 128 + c16 * 8); }
}
__device__ __forceinline__ void ssd_load_btx(SsdRegs& R, const bf16_t* BT, const bf16_t* ZX, int b, int g, int h, int chunk, int tid) {
    const int t0 = b * SEQ + chunk * 128; (void)BT; (void)g;
    const int grp = tid & 7, l0 = (tid >> 3) * 2;
    const bf16_t* src = ZX + (size_t)(t0 + l0 - 3) * ZXW + D_INNER + h * 64 + grp * 8;
#pragma unroll
    for (int r = 0; r < 5; ++r) { if (chunk == 0 && l0 + r < 3) R.x[r] = (u32x4){0u, 0u, 0u, 0u}; else R.x[r] = *(const u32x4*)(src + (size_t)r * ZXW); }
}
__device__ __forceinline__ void ssd_scan(LAS unsigned char* lds, int par, float d0, float d1, float Acoef, float Dsk, int lane) {
    LAS float* acs = (LAS float*)(lds + L_ACS + par * 512); LAS float* dts = (LAS float*)(lds + L_DTS + par * 512); LAS float* wdec = (LAS float*)(lds + L_WDEC + par * 512);
    LAS float* dskv = (LAS float*)(lds + L_DSK + par * 512);
    const float a0 = d0 * Acoef, a1 = d1 * Acoef; float s = a0 + a1;
#pragma unroll
    for (int o = 1; o < 64; o <<= 1) { const float n = __shfl_up(s, o); if (lane >= o) s += n; }
    const float last = __shfl(s, 63);
    acs[2 * lane] = s - a1; acs[2 * lane + 1] = s; dts[2 * lane] = d0; dts[2 * lane + 1] = d1;
    wdec[2 * lane] = __expf(last - (s - a1)); wdec[2 * lane + 1] = __expf(last - s);
    dskv[2 * lane] = Dsk / fmaxf(d0, 1e-30f); dskv[2 * lane + 1] = Dsk / fmaxf(d1, 1e-30f);
}

__device__ __forceinline__ void ssd_phase(CArgs& a, LAS unsigned char* lds, int tid, int wave, int lane) {
    unsigned char* ws = a.ws;
    bf16_t* ZX = (bf16_t*)(ws + WS_ZX); const float* DT = (const float*)(ws + WS_DT); float* SSQ = (float*)(ws + WS_SSQ);
    const bf16_t* BCc = (const bf16_t*)(ws + WS_BCC); const bf16_t* BT = (const bf16_t*)(ws + WS_BT);
    const float* conv_w = a.in[3]; const float* conv_b = a.in[4]; const float* a_log = a.in[6]; const float* d_skip = a.in[7];
    const int pt = wave & 3, lh = wave >> 2;
#define SSD_LAUNDER() int vt = tid; asm volatile("" : "+v"(vt)); const int fr = vt & 15, fq = (vt >> 4) & 3; (void)fr; (void)fq
    LAS bf16_t* Bs = (LAS bf16_t*)(lds + L_BS); LAS bf16_t* Btw = (LAS bf16_t*)(lds + L_BTW); LAS bf16_t* Cs = (LAS bf16_t*)(lds + L_CS);
    LAS bf16_t* Ms = (LAS bf16_t*)(lds + L_MS); LAS bf16_t* XDt = (LAS bf16_t*)(lds + L_XDT);
    LAS float* ssqp = (LAS float*)(lds + L_SSQ);
    constexpr float LOG2E = 1.44269504088896f;
    const int vcu_s = (gridDim.x % 8 == 0) ? (int)(blockIdx.x % 8) * (int)(gridDim.x / 8) + (int)(blockIdx.x / 8) : (int)blockIdx.x;
    for (int unit = vcu_s; unit < BATCH * SSM_HEADS; unit += gridDim.x) {
        const int b = unit >> 5, h = unit & 31, g = h >> 3;
        const float Acoef = -__expf(a_log[h]), Dsk = d_skip[h];
        f32x4 St[4];
#pragma unroll
        for (int i = 0; i < 4; ++i) St[i] = (f32x4){0.f, 0.f, 0.f, 0.f};
        { LAS u32x4* ex = (LAS u32x4*)(lds + L_EX) + (wave * 2) * 64 + lane; ex[0] = (u32x4){0u, 0u, 0u, 0u}; ex[64] = (u32x4){0u, 0u, 0u, 0u}; }
        if (tid < 8) { const int chan = h * 64 + tid * 8; LAS f32x4* tp = (LAS f32x4*)(lds + L_BTW) + tid * 10;
#pragma unroll
          for (int half = 0; half < 2; ++half) {
#pragma unroll
              for (int j = 0; j < 4; ++j) tp[half * 5 + j] = *(const f32x4*)(conv_w + j * CONV_DIM + chan + 4 * half);
              tp[half * 5 + 4] = *(const f32x4*)(conv_b + chan + 4 * half); } }
        SsdRegs R;
        ssd_load_bc(R, BCc, b, g, 0, tid); ssd_load_btx(R, BT, ZX, b, g, h, 0, tid);
        float dn0 = 0.f, dn1 = 0.f;
        if (wave == 7) { const int t0 = b * SEQ; ssd_scan(lds, 0, DT[(size_t)(t0 + 2 * lane) * 32 + h], DT[(size_t)(t0 + 2 * lane + 1) * 32 + h], Acoef, Dsk, lane); }
        for (int c = 0; c < SEQ / 128; ++c) {
            const int t0 = b * SEQ + c * 128;
            LAS float* acs = (LAS float*)(lds + L_ACS + (c & 1) * 512); LAS float* dts = (LAS float*)(lds + L_DTS + (c & 1) * 512); LAS float* wdec = (LAS float*)(lds + L_WDEC + (c & 1) * 512);
            LAS float* dskv = (LAS float*)(lds + L_DSK + (c & 1) * 512);
            LDS_BARRIER();
            { SSD_LAUNDER();
            if (wave == 7 && c + 1 < SEQ / 128) { dn0 = DT[(size_t)(t0 + 128 + 2 * (vt & 63)) * 32 + h]; dn1 = DT[(size_t)(t0 + 128 + 2 * (vt & 63) + 1) * 32 + h]; }
            { const int row = vt >> 4, c16 = vt & 15;
#pragma unroll
              for (int k = 0; k < 4; ++k) { const int l = row + 32 * k;
                  *(LAS u32x4*)(Bs + l * SST + c16 * 8) = R.b[k]; *(LAS u32x4*)(Cs + l * SST + c16 * 8) = R.c[k]; } }
            {
                const int grp = vt & 7, l0 = (vt >> 3) * 2;
                const float d0 = dts[l0], d1 = dts[l0 + 1];
                const LAS f32x4* tp = (const LAS f32x4*)(lds + L_BTW) + grp * 10;
#pragma unroll
                for (int half = 0; half < 2; ++half) {
                    f32x4 cwx[2][4], cbx[2];
#pragma unroll
                    for (int j = 0; j < 4; ++j) cwx[half][j] = tp[half * 5 + j];
                    cbx[half] = tp[half * 5 + 4];
#pragma unroll
                    for (int i = 0; i < 4; ++i) {
                        float s0 = cbx[half][i], s1 = s0;
#pragma unroll
                        for (int j = 0; j < 4; ++j) { const unsigned w0 = R.x[j][2 * half + (i >> 1)], w1 = R.x[j + 1][2 * half + (i >> 1)];
                            s0 += cwx[half][j][i] * ((i & 1) ? bfhi(w0) : bflo(w0)); s1 += cwx[half][j][i] * ((i & 1) ? bfhi(w1) : bflo(w1)); }
                        *(LAS unsigned*)(XDt + (grp * 8 + 4 * half + i) * SST + l0) = cvt_pk_bf16(silu_f(s0) * d0, silu_f(s1) * d1);
                    }
                }
            }
            if (c > 0 && vt < 128) { const f32x4 p = *(LAS f32x4*)(ssqp + vt * 4); SSQ[(size_t)(t0 - 128 + vt) * 32 + h] = (p[0] + p[1]) + (p[2] + p[3]); }
            }
            LDS_BARRIER();
            u32x2 zr[4];
            { SSD_LAUNDER(); if (c + 1 < SEQ / 128) ssd_load_bc(R, BCc, b, g, c + 1, vt);
#pragma unroll
              for (int aa = 0; aa < 4; ++aa) zr[aa] = *(const u32x2*)(ZX + (size_t)(t0 + 16 * (lh + 2 * aa) + fr) * ZXW + h * 64 + 16 * pt + 4 * fq);
            }
            f32x4 yacc[4];
#pragma unroll
            for (int aa = 0; aa < 4; ++aa) yacc[aa] = (f32x4){0.f, 0.f, 0.f, 0.f};
            { SSD_LAUNDER();
#pragma unroll
            for (int ks = 0; ks < 4; ++ks) {
                bf16x8 sop;
                if ((ks >> 1) == lh) { const f32x4 s0 = St[2 * (ks & 1)], s1 = St[2 * (ks & 1) + 1]; u32x4 w; w.x = cvt_pk_bf16(s0[0], s0[1]); w.y = cvt_pk_bf16(s0[2], s0[3]); w.z = cvt_pk_bf16(s1[0], s1[1]); w.w = cvt_pk_bf16(s1[2], s1[3]); sop = __builtin_bit_cast(bf16x8, w); }
                else sop = *(const LAS bf16x8*)(lds + L_EX + (((c & 1) * 8 + (wave ^ 4)) * 2 + (ks & 1)) * 1024 + (vt & 63) * 16);
#pragma unroll
                for (int aa = 0; aa < 4; ++aa) { const int lt = lh + 2 * aa; const LAS bf16_t* cp = Cs + (16 * lt + fr) * SST + 32 * ks + 4 * fq;
                    const u32x2 lo = *(const LAS u32x2*)cp, hi = *(const LAS u32x2*)(cp + 16); u32x4 w; w.x = lo.x; w.y = lo.y; w.z = hi.x; w.w = hi.y;
                    yacc[aa] = __builtin_amdgcn_mfma_f32_16x16x32_bf16(sop, __builtin_bit_cast(bf16x8, w), yacc[aa], 0, 0, 0); }
                asm volatile("" ::: "memory");
            }
#pragma unroll
            for (int aa = 0; aa < 4; ++aa) yacc[aa] *= __expf(acs[16 * (lh + 2 * aa) + fr]);
            }
            { SSD_LAUNDER();
                const float dec = __expf(acs[127]);
#pragma unroll
                for (int i = 0; i < 4; ++i) St[i] *= dec;
#pragma unroll 1
                for (int ks = 0; ks < 4; ++ks) {
                    const u32x4 xr = *(const LAS u32x4*)(XDt + (16 * pt + fr) * SST + 32 * ks + 8 * fq);
                    const f32x4 w0 = *(const LAS f32x4*)(wdec + 32 * ks + 8 * fq), w1 = *(const LAS f32x4*)(wdec + 32 * ks + 8 * fq + 4);
                    u32x4 xs; xs.x = cvt_pk_bf16(bflo(xr.x) * w0[0], bfhi(xr.x) * w0[1]); xs.y = cvt_pk_bf16(bflo(xr.y) * w0[2], bfhi(xr.y) * w0[3]);
                    xs.z = cvt_pk_bf16(bflo(xr.z) * w1[0], bfhi(xr.z) * w1[1]); xs.w = cvt_pk_bf16(bflo(xr.w) * w1[2], bfhi(xr.w) * w1[3]);
                    const bf16x8 bop = __builtin_bit_cast(bf16x8, xs);
#pragma unroll
                    for (int j = 0; j < 4; ++j) {
                        LAS bf16x4* tp = (LAS bf16x4*)(Bs + (32 * ks + 8 * fq + (fr >> 2)) * SST + 16 * (4 * lh + j) + 4 * (fr & 3));
                        const bf16x4 t0v = __builtin_amdgcn_ds_read_tr16_b64_v4i16(tp), t1v = __builtin_amdgcn_ds_read_tr16_b64_v4i16((LAS bf16x4*)((LAS bf16_t*)tp + 4 * SST));
                        const bf16x8 aop = {t0v[0], t0v[1], t0v[2], t0v[3], t1v[0], t1v[1], t1v[2], t1v[3]};
                        St[j] = __builtin_amdgcn_mfma_f32_16x16x32_bf16(aop, bop, St[j], 0, 0, 0); }
                    asm volatile("" ::: "memory");
                }
#pragma unroll
                for (int k2 = 0; k2 < 2; ++k2) { const f32x4 s0 = St[2 * k2], s1 = St[2 * k2 + 1]; u32x4 w; w.x = cvt_pk_bf16(s0[0], s0[1]); w.y = cvt_pk_bf16(s0[2], s0[3]); w.z = cvt_pk_bf16(s1[0], s1[1]); w.w = cvt_pk_bf16(s1[2], s1[3]);
                    *(LAS u32x4*)(lds + L_EX + ((((c + 1) & 1) * 8 + wave) * 2 + k2) * 1024 + (vt & 63) * 16) = w; }
            }
            { SSD_LAUNDER();
                int lt = 0, i = wave;
                while (i > lt) { i -= lt + 1; ++lt; }
                while (lt < 8) {
                    f32x4 gacc = {0.f, 0.f, 0.f, 0.f};
#pragma unroll
                    for (int ks = 0; ks < 4; ++ks) { const bf16x8 aop = *(const LAS bf16x8*)(Bs + (16 * i + fr) * SST + 32 * ks + 8 * fq), bop = *(const LAS bf16x8*)(Cs + (16 * lt + fr) * SST + 32 * ks + 8 * fq);
                        gacc = __builtin_amdgcn_mfma_f32_16x16x32_bf16(aop, bop, gacc, 0, 0, 0); }
                    const int l = 16 * lt + fr; const float al = acs[l] * LOG2E;
                    const f32x4 as4 = *(const LAS f32x4*)(acs + 16 * i + 4 * fq);
                    float mv[4];
#pragma unroll
                    for (int j = 0; j < 4; ++j) mv[j] = gacc[j] * __builtin_amdgcn_exp2f(al - as4[j] * LOG2E);
                    if (i == lt) { const float dk = dskv[l];
#pragma unroll
                        for (int j = 0; j < 4; ++j) { const int sr = 4 * fq + j; mv[j] = sr <= fr ? mv[j] : 0.f; if (sr == fr) mv[j] += dk; }
                        if ((lt & 1) == 0) *(LAS u32x2*)(Ms + l * SST + 16 * (i + 1) + 4 * fq) = (u32x2){0u, 0u}; }
                    u32x2 w; w.x = cvt_pk_bf16(mv[0], mv[1]); w.y = cvt_pk_bf16(mv[2], mv[3]);
                    *(LAS u32x2*)(Ms + l * SST + 16 * i + 4 * fq) = w;
                    i += 8; while (lt < 8 && i > lt) { i -= lt + 1; ++lt; }
                }
            }
            { SSD_LAUNDER();
            if (c + 1 < SEQ / 128) ssd_load_btx(R, BT, ZX, b, g, h, c + 1, vt);
            if (wave == 7 && c + 1 < SEQ / 128) ssd_scan(lds, (c + 1) & 1, dn0, dn1, Acoef, Dsk, vt & 63);
            }
            LDS_BARRIER();
            { SSD_LAUNDER();
#pragma unroll
            for (int aa = 0; aa < 4; ++aa) { const int lt = lh + 2 * aa;
                for (int ks = 0; ks <= (lt >> 1); ++ks) { const bf16x8 mop = *(const LAS bf16x8*)(Ms + (16 * lt + fr) * SST + 32 * ks + 8 * fq), xop = *(const LAS bf16x8*)(XDt + (16 * pt + fr) * SST + 32 * ks + 8 * fq);
                    yacc[aa] = __builtin_amdgcn_mfma_f32_16x16x32_bf16(xop, mop, yacc[aa], 0, 0, 0); } }
#pragma unroll
            for (int aa = 0; aa < 4; ++aa) { const int l = 16 * (lh + 2 * aa) + fr;
                const float y0 = yacc[aa][0] * silu_f(bflo(zr[aa].x)), y1 = yacc[aa][1] * silu_f(bfhi(zr[aa].x)), y2 = yacc[aa][2] * silu_f(bflo(zr[aa].y)), y3 = yacc[aa][3] * silu_f(bfhi(zr[aa].y));
                u32x2 w; w.x = cvt_pk_bf16(y0, y1); w.y = cvt_pk_bf16(y2, y3);
                *(u32x2*)(ZX + (size_t)(t0 + l) * ZXW + h * 64 + 16 * pt + 4 * fq) = w;
                float q = (y0 * y0 + y1 * y1) + (y2 * y2 + y3 * y3); q += __shfl_xor(q, 16); q += __shfl_xor(q, 32);
                if (fq == 0) ssqp[l * 4 + pt] = q; }
            }
        }
        LDS_BARRIER();
        if (tid < 128) { const f32x4 p = *(LAS f32x4*)(ssqp + tid * 4); SSQ[(size_t)(b * SEQ + SEQ - 128 + tid) * 32 + h] = (p[0] + p[1]) + (p[2] + p[3]); }
        LDS_BARRIER();
    }
#undef SSD_LAUNDER
}

__device__ __forceinline__ void gatenorm_phase(CArgs& a, int gtid, int ngt) {
    bf16_t* ZX = (bf16_t*)(a.ws + WS_ZX); const float* SSQ = (const float*)(a.ws + WS_SSQ);
    for (int it = gtid; it < T * 256; it += 4 * ngt) {
        u32x4 v[4]; f32x4 s0[4], s1[4]; u32x4* p[4];
#pragma unroll
        for (int k = 0; k < 4; ++k) { int i2 = it + k * ngt; if (i2 >= T * 256) i2 = it; const int t = i2 >> 8, c8 = i2 & 255, g = c8 >> 6;
            p[k] = (u32x4*)(ZX + (size_t)t * ZXW + c8 * 8); v[k] = *p[k];
            s0[k] = *(const f32x4*)(SSQ + (size_t)t * 32 + 8 * g); s1[k] = *(const f32x4*)(SSQ + (size_t)t * 32 + 8 * g + 4); }
#pragma unroll
        for (int k = 0; k < 4; ++k) { if (k > 0 && it + k * ngt >= T * 256) continue;
            const float rstd = rsqrtf(((s0[k][0] + s0[k][1]) + (s0[k][2] + s0[k][3]) + (s1[k][0] + s1[k][1]) + (s1[k][2] + s1[k][3])) * (1.f / 512.f) + EPS);
            u32x4 w = v[k];
            w.x = cvt_pk_bf16(bflo(w.x) * rstd, bfhi(w.x) * rstd); w.y = cvt_pk_bf16(bflo(w.y) * rstd, bfhi(w.y) * rstd);
            w.z = cvt_pk_bf16(bflo(w.z) * rstd, bfhi(w.z) * rstd); w.w = cvt_pk_bf16(bflo(w.w) * rstd, bfhi(w.w) * rstd);
            *p[k] = w; }
    }
}

constexpr int AST = 72;
constexpr int L_KS = 0, L_VT = 9216, L_ABUF = 18432, L_FLG = 36864;
constexpr float ATT_DEAD = -150.1f;
template <bool MASK>
__device__ __forceinline__ void attn_tile(const LAS bf16_t* Ks, const LAS bf16_t* Vt, const bf16x8 (&qf)[2], f32x4 (&oacc)[4], float& carry, int c, int quad, int kbase, int qpos) {
    float z[16];
#pragma unroll
    for (int k16 = 0; k16 < 4; ++k16) {
        f32x4 sacc = {0.f, 0.f, 0.f, 0.f};
        const int krow = 16 * (c >> 2) + 4 * k16 + (c & 3);
#pragma unroll
        for (int ks = 0; ks < 2; ++ks) { const bf16x8 aop = *(const LAS bf16x8*)(Ks + krow * AST + 32 * ks + 8 * quad);
            sacc = __builtin_amdgcn_mfma_f32_16x16x32_bf16(aop, qf[ks], sacc, 0, 0, 0); }
#pragma unroll
        for (int j = 0; j < 4; ++j) z[4 * k16 + j] = sacc[j];
    }
    float ls[16], later[16], suf = 0.f;
#pragma unroll
    for (int i = 15; i >= 0; --i) {
        const float z2 = z[i];
        const float sp = fmaxf(z2, 0.f) + __builtin_amdgcn_logf(1.f + __builtin_amdgcn_exp2f(-fabsf(z2)));
        ls[i] = z2 - sp; later[i] = suf;
        if (MASK) { if ((kbase + i) < qpos) suf -= sp; } else suf -= sp;
    }
    const float T0 = __shfl(suf, c), T1 = __shfl(suf, c + 16), T2 = __shfl(suf, c + 32), T3 = __shfl(suf, c + 48);
    const float qoff = carry + (quad < 1 ? T1 : 0.f) + (quad < 2 ? T2 : 0.f) + (quad < 3 ? T3 : 0.f);
    carry += (T0 + T1) + (T2 + T3);
    float p[16];
#pragma unroll
    for (int i = 0; i < 16; ++i) { float v = __builtin_amdgcn_exp2f(ls[i] + later[i] + qoff); if (MASK) { if (!((kbase + i) < qpos)) v = 0.f; } p[i] = v; }
#pragma unroll
    for (int s = 0; s < 2; ++s) {
        u32x4 w; w.x = cvt_pk_bf16(p[8 * s + 0], p[8 * s + 1]); w.y = cvt_pk_bf16(p[8 * s + 2], p[8 * s + 3]); w.z = cvt_pk_bf16(p[8 * s + 4], p[8 * s + 5]); w.w = cvt_pk_bf16(p[8 * s + 6], p[8 * s + 7]);
        const bf16x8 pa = __builtin_bit_cast(bf16x8, w);
#pragma unroll
        for (int dt = 0; dt < 4; ++dt) { const bf16x8 bop = *(const LAS bf16x8*)(Vt + (16 * dt + c) * AST + 16 * quad + 8 * s);
            oacc[dt] = __builtin_amdgcn_mfma_f32_16x16x32_bf16(pa, bop, oacc[dt], 0, 0, 0); }
    }
}
__device__ __forceinline__ void attn_phase(CArgs& a, LAS unsigned char* lds, int tid, int wave, int lane) {
    const bf16_t* KVQ = (const bf16_t*)(a.ws + WS_KVQ); bf16_t* AO = (bf16_t*)(a.ws + WS_AO);
    LAS unsigned* flg = (LAS unsigned*)(lds + L_FLG);
    const int c = lane & 15, quad = lane >> 4;
    const int lkey = (tid & 31) + 32 * (tid >> 8), ldg = (tid >> 5) & 7;
    constexpr int NQB = SEQ / 128, NUNITS = BATCH * 16 * NQB;
    constexpr float QSC = 0.125f * 1.44269504088896f;
    u32x4 nq0, nq1, nkA, nvA, nkB, nvB;
#define ATT_PRELOAD(UNIT) { const int qb_ = (UNIT) % NQB, bh_ = (UNIT) / NQB, h_ = bh_ & 15, b_ = bh_ >> 4; const size_t tr_ = (size_t)b_ * SEQ; const int kt_ = 2 * qb_ + 1; \
        const bf16_t* qp_ = KVQ + (tr_ + 128 * qb_ + 16 * wave + c) * KVQW + 2048 + h_ * 64 + 8 * quad; nq0 = *(const u32x4*)qp_; nq1 = *(const u32x4*)(qp_ + 32); \
        const bf16_t* s_ = KVQ + (tr_ + lkey) * KVQW + h_ * 64 + 8 * ldg; \
        nkA = *(const u32x4*)(s_ + (size_t)(64 * kt_) * KVQW); nvA = *(const u32x4*)(s_ + (size_t)(64 * kt_) * KVQW + 1024); \
        nkB = *(const u32x4*)(s_ + (size_t)(64 * (kt_ - 1)) * KVQW); nvB = *(const u32x4*)(s_ + (size_t)(64 * (kt_ - 1)) * KVQW + 1024); }
    const int vcu_a = (gridDim.x % 8 == 0) ? (int)(blockIdx.x % 8) * (int)(gridDim.x / 8) + (int)(blockIdx.x / 8) : (int)blockIdx.x;
    if (vcu_a < NUNITS) ATT_PRELOAD(vcu_a)
    for (int unit = vcu_a; unit < NUNITS; unit += gridDim.x) {
        const int qb = unit % NQB, bh = unit / NQB, h = bh & 15, b = bh >> 4;
        const int qw0 = 128 * qb + 16 * wave;
        const size_t trow = (size_t)b * SEQ;
        bf16x8 qf[2];
        { u32x4 w = nq0;
            w.x = cvt_pk_bf16(bflo(w.x) * QSC, bfhi(w.x) * QSC); w.y = cvt_pk_bf16(bflo(w.y) * QSC, bfhi(w.y) * QSC);
            w.z = cvt_pk_bf16(bflo(w.z) * QSC, bfhi(w.z) * QSC); w.w = cvt_pk_bf16(bflo(w.w) * QSC, bfhi(w.w) * QSC); qf[0] = __builtin_bit_cast(bf16x8, w);
            w = nq1;
            w.x = cvt_pk_bf16(bflo(w.x) * QSC, bfhi(w.x) * QSC); w.y = cvt_pk_bf16(bflo(w.y) * QSC, bfhi(w.y) * QSC);
            w.z = cvt_pk_bf16(bflo(w.z) * QSC, bfhi(w.z) * QSC); w.w = cvt_pk_bf16(bflo(w.w) * QSC, bfhi(w.w) * QSC); qf[1] = __builtin_bit_cast(bf16x8, w); }
        f32x4 oacc[4];
#pragma unroll
        for (int i = 0; i < 4; ++i) oacc[i] = (f32x4){0.f, 0.f, 0.f, 0.f};
        float carry = 0.f; bool wave_alive = true;
        if (tid < 16) flg[tid] = 1u;
        int kt = 2 * qb + 1;
        const bf16_t* src0 = KVQ + (trow + lkey) * KVQW + h * 64 + 8 * ldg;
        u32x4 kA = nkA, vA = nvA, kB = nkB, vB = nvB;
        if (unit + (int)gridDim.x < NUNITS) ATT_PRELOAD(unit + (int)gridDim.x)
#define ATT_STEP(KR, VR, ITV) { \
            LAS bf16_t* Ks = (LAS bf16_t*)(lds + ((ITV) & 1) * L_ABUF + L_KS); LAS bf16_t* Vt = (LAS bf16_t*)(lds + ((ITV) & 1) * L_ABUF + L_VT); \
            *(LAS u32x4*)(Ks + lkey * AST + 8 * ldg) = KR; \
            Vt[(8 * ldg + 0) * AST + lkey] = (bf16_t)(VR.x & 0xffffu); Vt[(8 * ldg + 1) * AST + lkey] = (bf16_t)(VR.x >> 16); \
            Vt[(8 * ldg + 2) * AST + lkey] = (bf16_t)(VR.y & 0xffffu); Vt[(8 * ldg + 3) * AST + lkey] = (bf16_t)(VR.y >> 16); \
            Vt[(8 * ldg + 4) * AST + lkey] = (bf16_t)(VR.z & 0xffffu); Vt[(8 * ldg + 5) * AST + lkey] = (bf16_t)(VR.z >> 16); \
            Vt[(8 * ldg + 6) * AST + lkey] = (bf16_t)(VR.w & 0xffffu); Vt[(8 * ldg + 7) * AST + lkey] = (bf16_t)(VR.w >> 16); \
            LDS_BARRIER(); \
            if ((ITV) > 0) { const u32x4 f0_ = *(const LAS u32x4*)(flg + (((ITV) - 1) & 1) * 8), f1_ = *(const LAS u32x4*)(flg + (((ITV) - 1) & 1) * 8 + 4); \
                if (!(((f0_.x | f0_.y) | (f0_.z | f0_.w)) | ((f1_.x | f1_.y) | (f1_.z | f1_.w)))) goto att_done; } \
            if (kt > 1) { KR = *(const u32x4*)(src0 + (size_t)(64 * (kt - 2)) * KVQW); VR = *(const u32x4*)(src0 + (size_t)(64 * (kt - 2)) * KVQW + 1024); }     \
            const int tk0 = 64 * kt; \
            if (wave_alive && tk0 < qw0 + 15) { \
                if (tk0 + 63 >= qw0) attn_tile<true>(Ks, Vt, qf, oacc, carry, c, quad, tk0 + 16 * quad, qw0 + c); \
                else attn_tile<false>(Ks, Vt, qf, oacc, carry, c, quad, tk0 + 16 * quad, qw0 + c); \
                wave_alive = __ballot(carry > ATT_DEAD) != 0ull; \
            } \
            if (lane == 0) flg[((ITV) & 1) * 8 + wave] = wave_alive ? 1u : 0u; \
            if (kt == 0) goto att_done; \
            --kt; }
        for (int it = 0;; it += 2) {
            ATT_STEP(kA, vA, it)
            ATT_STEP(kB, vB, it + 1)
        }
        att_done:;
#undef ATT_STEP
#pragma unroll
        for (int dt = 0; dt < 4; ++dt)
#pragma unroll
            for (int j = 0; j < 4; ++j) AO[(trow + qw0 + 4 * quad + j) * D_MODEL + h * 64 + 16 * dt + c] = (bf16_t)(cvt_pk_bf16(oacc[dt][j], 0.f) & 0xffffu);
        LDS_BARRIER();
    }
#undef ATT_PRELOAD
}

__device__ __forceinline__ void final_norm(const bf16_t* Hb, float* X, const float* w, int gw, int NGW, int lane, int npert) {
    f32x4 wv[4];
#pragma unroll
    for (int j = 0; j < 2; ++j) { wv[2 * j] = *(const f32x4*)(w + 512 * j + lane * 8); wv[2 * j + 1] = *(const f32x4*)(w + 512 * j + lane * 8 + 4); }
    for (int m = gw; m < T; m += NGW) {
        f32x4 v[4]; float s = 0.f;
#pragma unroll
        for (int j = 0; j < 2; ++j) { const u32x4 hb = *(const u32x4*)(Hb + (size_t)m * D_MODEL + 512 * j + lane * 8);
            v[2 * j] = (f32x4){bflo(hb.x), bfhi(hb.x), bflo(hb.y), bfhi(hb.y)}; v[2 * j + 1] = (f32x4){bflo(hb.z), bfhi(hb.z), bflo(hb.w), bfhi(hb.w)}; }
#pragma unroll
        for (int j = 0; j < 4; ++j) s += (v[j].x * v[j].x + v[j].y * v[j].y) + (v[j].z * v[j].z + v[j].w * v[j].w);
        const float rstd = rsqrtf(wave_sum(s) * (1.f / D_MODEL) + EPS);
#pragma unroll
        for (int j = 0; j < 4; ++j) { f32x4 o = v[j] * rstd * wv[j];
            const int fi = m * D_MODEL + 512 * (j >> 1) + lane * 8 + 4 * (j & 1);
            if (npert > 0) {
#pragma unroll
                for (int e = 0; e < 4; ++e) if (fi + e < npert) o[e] += 0.1f; }
            *(f32x4*)(X + fi) = o; }
    }
}

__device__ __forceinline__ void dt_gemm(const bf16_t* XNp, const bf16_t* WdtT  , const float* bias, float* DT, int gw, int NGW, int lane) {
    const int fr = lane & 15, fq = lane >> 4;
    for (int strip = gw; strip < T / 16; strip += NGW) {
        const bf16_t* ap = XNp + (size_t)(strip * 16 + fr) * 1024 + 8 * fq; const bf16_t* bp = WdtT + (size_t)fr * 1024 + 8 * fq;
        f32x4 a0 = {0.f, 0.f, 0.f, 0.f}, a1 = a0;
#pragma unroll 8
        for (int ks = 0; ks < 32; ++ks) { const bf16x8 av = *(const bf16x8*)(ap + 32 * ks), b0 = *(const bf16x8*)(bp + 32 * ks), b1 = *(const bf16x8*)(bp + 16 * 1024 + 32 * ks);
            a0 = __builtin_amdgcn_mfma_f32_16x16x32_bf16(av, b0, a0, 0, 0, 0); a1 = __builtin_amdgcn_mfma_f32_16x16x32_bf16(av, b1, a1, 0, 0, 0); }
        const float bb0 = bias[fr], bb1 = bias[16 + fr];
#pragma unroll
        for (int j = 0; j < 4; ++j) { float* o = DT + (size_t)(strip * 16 + 4 * fq + j) * 32; o[fr] = softplus_f(a0[j] + bb0); o[16 + fr] = softplus_f(a1[j] + bb1); }
    }
}

#define XB_TMO      128
#define XB_XCNT(j)  (256  + 64 * (j))
#define XB_XSUB(j)  (1280 + 64 * (j))
#define XB_XGEN(j)  (2304 + 64 * (j))
#define XB_TOP      3328
#define XB_TOPGEN   3392
#define XCD_BAR_WORDS 3456
#define XB_SPIN_CAP (1u << 22)
constexpr size_t WS_BAR = 65536;
constexpr int L_XB = 163840 - 16;
__device__ __forceinline__ unsigned xb_ld(unsigned* p)              { return __hip_atomic_load(p, __ATOMIC_RELAXED, __HIP_MEMORY_SCOPE_AGENT); }
__device__ __forceinline__ unsigned xb_add(unsigned* p, unsigned v) { return __hip_atomic_fetch_add(p, v, __ATOMIC_RELAXED, __HIP_MEMORY_SCOPE_AGENT); }
__device__ __forceinline__ unsigned xb_xcc_id() { return (unsigned)__builtin_amdgcn_s_getreg((3 << 11) | 20) & 0xFu; }
#define XB_SPIN(cond, bar) do { unsigned _sp = 0; while (cond) { __builtin_amdgcn_s_sleep(1); \
    if ((++_sp & 255u) == 0u) { if (xb_ld(&(bar)[XB_TMO])) break; if (_sp > XB_SPIN_CAP) { atomicAdd(&(bar)[XB_TMO], 1u); break; } } } } while (0)
__device__ __forceinline__ void xcd_barrier_complete(unsigned* bar, unsigned x, unsigned& nloc, unsigned& nx) {
    const unsigned G = gridDim.x * gridDim.y * gridDim.z;
    unsigned sum, cnt, mine, sp = 0u;
    for (;;) {
        sum = 0u; cnt = 0u; mine = 0u;
#pragma unroll
        for (unsigned j = 0; j < 16; ++j) { const unsigned c = xb_ld(&bar[XB_XCNT(j)]); sum += c; cnt += (c > 0u) ? 1u : 0u; mine = (j == x) ? c : mine; }
        if (sum == G) break;
        __builtin_amdgcn_s_sleep(1);
        if ((++sp & 255u) == 0u) { if (xb_ld(&bar[XB_TMO])) break; if (sp > XB_SPIN_CAP) { atomicAdd(&bar[XB_TMO], 1u); break; } }
    }
    nloc = mine > 0u ? mine : 1u; nx = cnt > 0u ? cnt : 1u;
}
__device__ __forceinline__ void xcd_barrier(unsigned* bar, volatile LAS unsigned* st) {
    asm volatile("s_waitcnt vmcnt(0)" ::: "memory");
    __syncthreads();
    if (threadIdx.x == 0) {
        const unsigned x = xb_xcc_id();
        __builtin_amdgcn_s_waitcnt(0);
        unsigned nloc = st[0], nx = st[1];
        if (nloc == 0u) { xcd_barrier_complete(bar, x, nloc, nx); st[0] = nloc; st[1] = nx; }
        const unsigned old = xb_add(&bar[XB_XSUB(x)], 1u);
        const unsigned gen = old / nloc;
        if (old + 1u == (gen + 1u) * nloc) {
            __builtin_amdgcn_fence(__ATOMIC_RELEASE, "agent");
            asm volatile("s_waitcnt vmcnt(0)" ::: "memory");
            const unsigned og = xb_add(&bar[XB_TOP], 1u);
            const unsigned tg = og / nx;
            if (og + 1u == (tg + 1u) * nx) xb_add(&bar[XB_TOPGEN], 1u);
            else XB_SPIN(xb_ld(&bar[XB_TOPGEN]) == tg, bar);
            __builtin_amdgcn_fence(__ATOMIC_ACQUIRE, "agent");
            xb_add(&bar[XB_XGEN(x)], 1u);
            asm volatile("s_waitcnt vmcnt(0)" ::: "memory");
        } else {
            XB_SPIN(xb_ld(&bar[XB_XGEN(x)]) == gen, bar);
            __builtin_amdgcn_fence(__ATOMIC_ACQUIRE, "agent");
            asm volatile("s_waitcnt vmcnt(0)" ::: "memory");
        }
    }
    __syncthreads();
}

constexpr int NPHASES = 13;
__device__ __forceinline__ CArgs& fresh_args() {
    CArgs* p = (CArgs*)__builtin_amdgcn_kernarg_segment_ptr();
    asm volatile("" : "+s"(p));
    return *p;
}
__global__ void __launch_bounds__(NTHREADS, 2) yoco_fwd(Args args_unused) {
#define args fresh_args()
    extern __shared__ __attribute__((aligned(16))) unsigned char lds_raw[];
    LAS unsigned char* lds = (LAS unsigned char*)lds_raw;
    const int tid = threadIdx.x, lane = tid & 63, wave = __builtin_amdgcn_readfirstlane(tid >> 6);
    const int G = gridDim.x, gw = blockIdx.x * 8 + wave, NGW = G * 8;
#define ws (args.ws)
#define XN ((bf16_t*)(ws + WS_XN))
#define H (args.out)
    const int lo = args.ph_lo, hi = args.ph_hi;
#define IN(k) (lo <= (k) && (k) < hi)
#define STAMP(k) do { if (MK_PROBE_A >= 0 && blockIdx.x == 0 && threadIdx.x == 0) ((unsigned long long*)ws)[k] = __builtin_amdgcn_s_memrealtime(); } while (0)
#define SEAM(k) do { if (IN(k) && IN((k) + 1)) xcd_barrier((unsigned*)(ws + WS_BAR), (volatile LAS unsigned*)(lds + L_XB)); STAMP((k) + 1); } while (0)
    if (hi - lo > 1) {
        if (tid < 2) ((volatile LAS unsigned*)(lds + L_XB))[tid] = 0u;
        __syncthreads();
        if (tid == 0) (void)xb_add(&((unsigned*)(ws + WS_BAR))[XB_XCNT(xb_xcc_id())], 1u);
    }
    if (lo < 0) cg::this_grid().sync();
    STAMP(0);
    if (IN(0)) { p0_prologue(args, lds, gw, NGW, wave, lane); } SEAM(0);
    if (IN(1)) {
        pg8::Gemm g{XN, (const bf16_t*)(ws + WS_WIN), nullptr}; pg8::StaticOrder<T / 256, ZXW / 256> S; S.init(G, blockIdx.x);
        pg8::EpiInProj E{(bf16_t*)(ws + WS_ZX)};
        pg8::gemm_phase<pg8::EpiInProj, false, true, 1024, 1024>(lds, g, S, E);
        dt_gemm(XN, (const bf16_t*)(ws + WS_WIN) + (size_t)ZXW * 1024, args.in[5], (float*)(ws + WS_DT), gw, NGW, lane);
    } SEAM(1);
    if (IN(2)) { bcconv_phase(args, lds, tid); } SEAM(2);
    if (IN(3)) { ssd_phase(args, lds, tid, wave, lane); } SEAM(3);
    if (IN(4)) {
        pg8::Gemm g{(const bf16_t*)(ws + WS_ZX), (const bf16_t*)(ws + WS_WOUT), (const float*)(ws + WS_SSQ)}; pg8::StaticOrder<T / 256, 4> S; S.init(G, blockIdx.x);
        pg8::EpiRes<true, true> E{args.in[0], XN, (float*)(ws + WS_SSQP), lds};
        pg8::gemm_phase<pg8::EpiRes<true, true>, false, true, 2048, ZXW, true>(lds, g, S, E);
    } SEAM(4);
#define FFN_BLOCK(layer, pb) \
    if (IN(pb)) { \
        pg8::Gemm g{XN, (const bf16_t*)(ws + WS_WUP) + (size_t)layer * FF2 * 1024, nullptr}; pg8::StaticOrder<133, 22> S; S.init(G, blockIdx.x); \
        pg8::EpiFfn E{(bf16_t*)(ws + WS_ACT), args.in[18] + (size_t)layer * 3 * FF2, args.in[19] + (size_t)layer * FF2, (const float*)(ws + WS_SSQP), lds}; \
        pg8::gemm_phase<pg8::EpiFfn, true, true, 1024, 1024>(lds, g, S, E); \
    } SEAM(pb); \
    if (IN(pb + 1)) { \
        pg8::Gemm g{(const bf16_t*)(ws + WS_ACT), (const bf16_t*)(ws + WS_WDN) + (size_t)layer * 1024 * D_FF, nullptr}; pg8::StaticOrder<T / 256, 4> S; S.init(G, blockIdx.x); \
        pg8::EpiRes<false> E{nullptr, XN, (float*)(ws + WS_SSQP), lds}; \
        pg8::gemm_phase<pg8::EpiRes<false>, false, true, D_FF, D_FF>(lds, g, S, E); \
    } SEAM(pb + 1);
    FFN_BLOCK(0, 5)
    if (IN(7)) {
        pg8::Gemm g{XN, (const bf16_t*)(ws + WS_WKVQ), nullptr}; pg8::StaticOrder<T / 256, KVQW / 256> S; S.init(G, blockIdx.x);
        pg8::EpiBf16 E{(bf16_t*)(ws + WS_KVQ), KVQW, (const float*)(ws + WS_SSQP), lds};
        pg8::gemm_phase<pg8::EpiBf16, false, true, 1024, 1024>(lds, g, S, E);
    } SEAM(7);
    if (IN(8)) { attn_phase(args, lds, tid, wave, lane); } SEAM(8);
    if (IN(9)) {
        pg8::Gemm g{(const bf16_t*)(ws + WS_AO), (const bf16_t*)(ws + WS_WO), nullptr}; pg8::StaticOrder<T / 256, 4> S; S.init(G, blockIdx.x);
        pg8::EpiRes<false> E{nullptr, XN, (float*)(ws + WS_SSQP), lds};
        pg8::gemm_phase<pg8::EpiRes<false>, false, true, 1024, 1024>(lds, g, S, E);
    } SEAM(9);
    FFN_BLOCK(1, 10)
#undef FFN_BLOCK
    if (IN(12)) { int npert = 0; if (MK_PROBE_A >= 0) { const unsigned long long* st = (const unsigned long long*)ws; npert = (int)((st[MK_PROBE_B < 0 ? 0 : MK_PROBE_B] - st[MK_PROBE_A < 0 ? 0 : MK_PROBE_A]) / 10ull); }
        final_norm(XN, H, args.in[21], gw, NGW, lane, npert); }
#undef IN
#undef SEAM
#undef ws
#undef XN
#undef H
#undef args
}

#ifndef MK_MULTI
#define MK_MULTI 0
#endif
extern "C" void kernel_launch(void* const* d_in, const int* in_sizes, int n_in, void* d_out, int out_size, void* d_ws, size_t ws_size, hipStream_t stream) {
    static int grid = 0;
    if (grid == 0) {
        if (n_in != 22 || out_size != T * D_MODEL || ws_size < WS_END) { fprintf(stderr, "kernel_launch: unexpected sizes n_in %d out %d ws %zu\n", n_in, out_size, ws_size); grid = -1; return; }
        int dev = 0, cus = 0, per_cu = 0;
        hipGetDevice(&dev); hipDeviceGetAttribute(&cus, hipDeviceAttributeMultiprocessorCount, dev);
        if (hipFuncSetAttribute((const void*)yoco_fwd, hipFuncAttributeMaxDynamicSharedMemorySize, LDS_BYTES) != hipSuccess) { fprintf(stderr, "kernel_launch: hipFuncSetAttribute failed\n"); grid = -1; return; }
        if (hipOccupancyMaxActiveBlocksPerMultiprocessor(&per_cu, (const void*)yoco_fwd, NTHREADS, LDS_BYTES) != hipSuccess || per_cu < 1) per_cu = 1;
        (void)hipGetLastError();
        grid = cus * per_cu;
        fprintf(stderr, "kernel_launch: grid %d (cus %d x %d)\n", grid, cus, per_cu);
    }
    if (grid < 0) return;
    (void)hipMemsetAsync((char*)d_ws + WS_BAR, 0, 16384, stream);
    Args a{};
    for (int i = 0; i < 22; ++i) a.in[i] = (const float*)d_in[i];
    a.out = (float*)d_out; a.ws = (unsigned char*)d_ws;
#if MK_MULTI
    for (int p = 0; p < NPHASES; ++p) { a.ph_lo = p; a.ph_hi = p + 1; hipLaunchKernelGGL(yoco_fwd, dim3(grid), dim3(NTHREADS), LDS_BYTES, stream, a); }
#else
    a.ph_lo = 0; a.ph_hi = NPHASES;
    void* kargs[] = {&a};
    hipError_t e = hipLaunchCooperativeKernel((const void*)yoco_fwd, dim3(grid), dim3(NTHREADS), kargs, LDS_BYTES, stream);
    if (e != hipSuccess) fprintf(stderr, "cooperative launch failed: %s (grid %d)\n", hipGetErrorString(e), grid);
#endif
}
```
